# Optimizing an MI355X kernel written in HIP

```python
import math
import jax, jax.numpy as jnp
from jax import lax
import numpy as np

D_MODEL = 1024
BATCH = 4
SEQ = 8192
DEPTH = 4

META_TOKENS = 16
POOL_WIDTH = D_MODEL
POOL_WINDOWS = (2, 4, 8, 16)
POOL_GROUPS = len(POOL_WINDOWS)
POOL_GROUP_DIM = POOL_WIDTH // POOL_GROUPS
N_HEADS = 16
HEAD_DIM = 64
ATTN_WIDTH = N_HEADS * HEAD_DIM
Q_BLOCK = 128
ATTN_PAD = (-META_TOKENS) % Q_BLOCK
D_FF = int(math.ceil(8 * D_MODEL / 3 / 256) * 256)
RMS_EPS = 1e-6
NEG_INF = -1e30
SPLIT_SIZES = (POOL_WIDTH, ATTN_WIDTH, ATTN_WIDTH, ATTN_WIDTH, N_HEADS, D_MODEL, D_MODEL)
SPLIT_POINTS = tuple(int(v) for v in np.cumsum(SPLIT_SIZES)[:-1])
N_IN = int(sum(SPLIT_SIZES))

kernel_name = "gated_pool_forgetting_attn_hybrid"


def rms_norm(x, g):
    xf = x.astype(jnp.float32)
    y = xf * lax.rsqrt(jnp.mean(xf * xf, axis=-1, keepdims=True) + RMS_EPS)
    return (y * g.astype(jnp.float32)).astype(x.dtype)


def multiscale_pool(u, w_pool, scale):
    B, T, _ = u.shape
    ug = u.reshape(B, T, POOL_GROUPS, POOL_GROUP_DIM)
    c0 = jnp.concatenate(
        [jnp.zeros((B, 1, POOL_GROUPS, POOL_GROUP_DIM), jnp.float32),
         jnp.cumsum(ug.astype(jnp.float32), axis=1)], axis=1)
    pos1 = jnp.arange(1, T + 1)
    outs = []
    for g, w in enumerate(POOL_WINDOWS):
        lag_idx = jnp.maximum(pos1 - w, 0)
        window_sum = c0[:, 1:, g] - jnp.take(c0[:, :, g], lag_idx, axis=1)
        count = jnp.minimum(pos1, w).astype(jnp.float32)[None, :, None]
        diff = (window_sum / count).astype(u.dtype) - ug[:, :, g]
        outs.append(jnp.einsum('btc,cd->btd', diff, w_pool[g]))
    return jnp.concatenate(outs, axis=-1) * scale


def forgetting_attention(q, k, v, log_f):
    B, T, H, Dh = q.shape
    pad4 = ((0, 0), (ATTN_PAD, 0), (0, 0), (0, 0))
    q = jnp.pad(q, pad4)
    k = jnp.pad(k, pad4)
    v = jnp.pad(v, pad4)
    F = jnp.cumsum(jnp.pad(log_f.astype(jnp.float32), ((0, 0), (ATTN_PAD, 0), (0, 0))), axis=1)
    L = T + ATTN_PAD
    n_blocks = L // Q_BLOCK
    key_pos = jnp.arange(L)
    key_valid = key_pos >= ATTN_PAD
    F_k = jnp.transpose(F, (0, 2, 1))[:, :, None, :]
    scale = 1.0 / math.sqrt(Dh)

    def block(i):
        start = i * Q_BLOCK
        qb = lax.dynamic_slice_in_dim(q, start, Q_BLOCK, axis=1)
        Fq = lax.dynamic_slice_in_dim(F, start, Q_BLOCK, axis=1)
        s = jnp.einsum('bqhd,bkhd->bhqk', qb, k, preferred_element_type=jnp.float32) * scale
        s = s + jnp.transpose(Fq, (0, 2, 1))[:, :, :, None] - F_k
        q_pos = start + jnp.arange(Q_BLOCK)
        mask = (key_pos[None, :] <= q_pos[:, None]) & key_valid[None, :]
        s = jnp.where(mask[None, None], s, NEG_INF)
        p = jax.nn.softmax(s, axis=-1)
        return jnp.einsum('bhqk,bkhd->bqhd', p.astype(v.dtype), v)

    out = lax.map(block, jnp.arange(n_blocks))
    out = jnp.transpose(out, (1, 0, 2, 3, 4)).reshape(B, L, H, Dh)
    return out[:, ATTN_PAD:]


def setup_inputs(seed: int = 0) -> dict:
    key = jax.random.key(seed)
    ks = jax.random.split(key, 16)
    f32 = jnp.float32
    nrm = lambda k, shape, s: jax.random.normal(k, shape, f32) * s
    gain = lambda k: 1.0 + 0.05 * jax.random.normal(k, (DEPTH, D_MODEL), f32)
    return {
        "x": jax.random.normal(ks[0], (BATCH, SEQ, D_MODEL), f32),
        "meta_tokens": nrm(ks[1], (META_TOKENS, D_MODEL), 1.0),
        "norm_mix_pre": gain(ks[2]),
        "norm_mix_post": gain(ks[3]),
        "norm_ffn_pre": gain(ks[4]),
        "norm_ffn_post": gain(ks[5]),
        "w_in": nrm(ks[6], (DEPTH, D_MODEL, N_IN), D_MODEL ** -0.5),
        "b_forget": jax.random.uniform(ks[7], (DEPTH, N_HEADS), f32, 1.0, 4.0),
        "w_pool": nrm(ks[8], (DEPTH, POOL_GROUPS, POOL_GROUP_DIM, POOL_GROUP_DIM), POOL_GROUP_DIM ** -0.5),
        "pool_scale": 1.0 + 0.05 * jax.random.normal(ks[9], (DEPTH, D_MODEL), f32),
        "w_out": nrm(ks[10], (DEPTH, D_MODEL, D_MODEL), D_MODEL ** -0.5),
        "w_ffn_gate": nrm(ks[11], (DEPTH, D_MODEL, D_FF), D_MODEL ** -0.5),
        "w_ffn_up": nrm(ks[12], (DEPTH, D_MODEL, D_FF), D_MODEL ** -0.5),
        "w_ffn_down": nrm(ks[13], (DEPTH, D_FF, D_MODEL), D_FF ** -0.5),
    }


def reference(x, meta_tokens, norm_mix_pre, norm_mix_post, norm_ffn_pre, norm_ffn_post,
              w_in, b_forget, w_pool, pool_scale, w_out, w_ffn_gate, w_ffn_up, w_ffn_down):
    B = x.shape[0]
    meta = jnp.broadcast_to(meta_tokens[None].astype(x.dtype), (B, META_TOKENS, D_MODEL))
    h_res = jnp.concatenate([meta, x], axis=1)
    T = h_res.shape[1]
    for l in range(DEPTH):
        h = rms_norm(h_res, norm_mix_pre[l])
        proj = jnp.einsum('btd,dn->btn', h, w_in[l])
        u_pool, q, k, v, f_logit, g_pool, g_attn = jnp.split(proj, SPLIT_POINTS, axis=-1)
        y_pool = multiscale_pool(u_pool, w_pool[l], pool_scale[l])
        log_f = jax.nn.log_sigmoid(f_logit.astype(jnp.float32) + b_forget[l].astype(jnp.float32))
        y_attn = forgetting_attention(
            q.reshape(B, T, N_HEADS, HEAD_DIM), k.reshape(B, T, N_HEADS, HEAD_DIM),
            v.reshape(B, T, N_HEADS, HEAD_DIM), log_f).reshape(B, T, ATTN_WIDTH)
        merged = jax.nn.sigmoid(g_pool) * y_pool + jax.nn.sigmoid(g_attn) * y_attn
        mix_out = jnp.einsum('btd,de->bte', merged, w_out[l])
        h_res = h_res + rms_norm(mix_out, norm_mix_post[l])
        h = rms_norm(h_res, norm_ffn_pre[l])
        ff = jax.nn.silu(jnp.einsum('btd,df->btf', h, w_ffn_gate[l])) * jnp.einsum('btd,df->btf', h, w_ffn_up[l])
        ff_out = jnp.einsum('btf,fd->btd', ff, w_ffn_down[l])
        h_res = h_res + rms_norm(ff_out, norm_ffn_post[l])
    return h_res[:, META_TOKENS:]
```

```cpp
#include <hip/hip_runtime.h>
#include <hip/hip_cooperative_groups.h>
#include <cstdio>
#include <cstdint>
namespace cg = cooperative_groups;

#define LAS __attribute__((address_space(3)))
__device__ __forceinline__ int tid_opaque() { int t = threadIdx.x; asm volatile("" : "+v"(t)); return t; }
typedef unsigned short bf16_t;
typedef short bf16x8 __attribute__((ext_vector_type(8)));
typedef short s16x4 __attribute__((ext_vector_type(4)));
typedef float f32x4 __attribute__((ext_vector_type(4)));
typedef float f32x2 __attribute__((ext_vector_type(2)));
typedef float f32x16 __attribute__((ext_vector_type(16)));
typedef unsigned u32x4 __attribute__((ext_vector_type(4)));
typedef unsigned u32x2 __attribute__((ext_vector_type(2)));
typedef __bf16 bf16x2_t __attribute__((ext_vector_type(2)));

constexpr int NB = 4, SEQ = 8192, META = 16, TT = SEQ + META, DM = 1024, NH = 16, HD = 64, DFF = 2816, DEPTH = 4;
constexpr int MREAL = NB * TT;
constexpr int MP = 33024;
constexpr int MM = NB * SEQ;
constexpr int NIN_SRC = 6160;
constexpr int NIN = 6400;
constexpr int NGU = 2 * DFF;
constexpr float RMS_EPS = 1e-6f;
constexpr float LOG2E = 1.4426950408889634f;
constexpr float C2 = 0.125f * LOG2E;
constexpr float NEGBIG = -1e30f;
__device__ __forceinline__ int compact_row(int b, int t) { return t < META ? MM + b * META + t : b * SEQ + (t - META); }

constexpr size_t MiB = 1u << 20;
constexpr size_t WS_CTL = 0;
constexpr size_t WS_LOGF = 1 * MiB;
constexpr size_t WS_FB = 4 * MiB;
constexpr size_t WS_RSTD = 7 * MiB;
constexpr size_t WS_WIN = 8 * MiB;
constexpr size_t WS_WOUT = 21 * MiB;
constexpr size_t WS_WGU = 23 * MiB;
constexpr size_t WS_WDN = 34 * MiB;
constexpr size_t SLOT = 65 * MiB;
constexpr size_t WS_HB = 40 * MiB;
constexpr size_t WS_Z = WS_HB + SLOT;
constexpr size_t WS_V = WS_Z + 3 * SLOT;
constexpr size_t WS_MIX = WS_V;
constexpr size_t WS_FF = WS_Z;
constexpr size_t WS_END = WS_Z + 6 * SLOT;
static_assert((size_t)MP * DM * 2 <= SLOT, "slot");
static_assert((size_t)MP * DFF * 2 <= 3 * SLOT, "ff overlay");
static_assert((size_t)NIN * DM * 2 <= 13 * MiB && (size_t)NGU * DM * 2 <= 11 * MiB && (size_t)DM * DFF * 2 <= 6 * MiB, "weights");

#ifndef PROBE_A_REPS
#define PROBE_A_REPS 1
#endif
#ifndef PROBE_C_REPS
#define PROBE_C_REPS 1
#endif
#ifndef PROBE_D_REPS
#define PROBE_D_REPS 1
#endif
#ifndef PROBE_E_REPS
#define PROBE_E_REPS 1
#endif
#ifndef PROBE_GEMM_REPS
#define PROBE_GEMM_REPS 1
#endif
#ifndef PROBE_ATT_REPS
#define PROBE_ATT_REPS 1
#endif
#ifndef PROBE_S_REPS
#define PROBE_S_REPS 1
#endif
#ifndef PROBE_CONV_REPS
#define PROBE_CONV_REPS 1
#endif
#ifndef PROBE_NORM_DRY
#define PROBE_NORM_DRY 0
#endif
#ifndef PROBE_SYNC_REPS
#define PROBE_SYNC_REPS 1
#endif
#define GSYNC() do { _Pragma("unroll 1") for (int rep_ = 0; rep_ < PROBE_SYNC_REPS; ++rep_) xcd_barrier((unsigned*)(params_opaque()->ws + WS_CTL) + CW_BAR, (volatile LAS unsigned*)(lds + LDS_XB)); } while (0)
constexpr int LDS_BYTES = 147456;
constexpr int LDS_BF = 139264;

namespace pg8 {
constexpr int BM = 256, BK = 64, HALF = 128, HTB = HALF * BK * 2, STAGE_BYTES = 8 * HTB, NXCD = 8, WGM = 4;
__host__ __device__ __forceinline__ int lds_byte(int r, int c) { const int st = (r >> 4) * 2 + (c >> 5), rr = r & 15, cc = c & 31, ob = rr * 64 + cc * 2; return st * 1024 + (ob ^ (((ob >> 9) & 1) << 5)); }
__host__ __device__ __forceinline__ void stage_rc(int b, int& R, int& C) { const int st = b / 1024, sb = b % 1024, swz = sb ^ (((sb >> 9) & 1) << 5); R = (st >> 1) * 16 + swz / 64; C = (st & 1) * 32 + (swz % 64) / 2; }
__host__ __device__ __forceinline__ int perm32(int rho) { const int n = rho >> 4, i = rho & 15; return 8 * (i >> 2) + 4 * n + (i & 3); }
struct Unit { int pm, pn; };
struct Gemm { const bf16_t* A; const bf16_t* Bt; int M, N, K; };
struct StaticOrder {
    int nM, nN, nwg, G, c;
    __device__ void init(int M, int N, int G_, int c_) { nM = M / BM; nN = N / BM; nwg = nM * nN; G = G_; c = c_; }
    __device__ bool next(int i, Unit& u) const {
        const long L = (long)i * G + c; if (L >= nwg) return false;
        int wgid = (int)L; { const int q = nwg / NXCD, r = nwg % NXCD, xcd = wgid % NXCD, off = wgid / NXCD; wgid = (xcd < r ? xcd * (q + 1) : r * (q + 1) + (xcd - r) * q) + off; }
        const int nig = WGM * nN, gid = wgid / nig, fm = gid * WGM, gsz = (nM - fm) < WGM ? (nM - fm) : WGM;
        u.pm = fm + ((wgid % nig) % gsz); u.pn = (wgid % nig) / gsz; return true;
    }
    __device__ __forceinline__ void a_ready(const Unit&) const {}
    __device__ __forceinline__ void done(const Unit&) const {}
};
__device__ __forceinline__ unsigned cvt_pk_bf16(float lo, float hi) { typedef float f2_ __attribute__((ext_vector_type(2))); typedef __bf16 b2_ __attribute__((ext_vector_type(2))); f2_ v = {lo, hi}; b2_ b = __builtin_convertvector(v, b2_); return __builtin_bit_cast(unsigned, b); }
__device__ __forceinline__ float sigmoidf_(float x) { return __builtin_amdgcn_rcpf(1.0f + __builtin_amdgcn_exp2f(-x * LOG2E)); }

struct EpiPlain {
    static constexpr bool PERM = true, AFTER_DRAIN = false;
    bf16_t* O; int ldc;
    __device__ __forceinline__ void operator()(const f32x4 (&acc)[2][2][4][2], const Unit& u, int wr, int wc, int fr, int fq) const {
        const int row0 = u.pm * BM + wr * 64 + fr; const int col0 = u.pn * BM + wc * 32 + 8 * fq;
#pragma unroll
        for (int ai = 0; ai < 2; ++ai)
#pragma unroll
            for (int m = 0; m < 4; ++m) { bf16_t* rowp = O + (size_t)(row0 + ai * HALF + m * 16) * ldc + col0;
#pragma unroll
                for (int bj = 0; bj < 2; ++bj) { const f32x4 v0 = acc[ai][bj][m][0], v1 = acc[ai][bj][m][1];
                    u32x4 w; w.x = cvt_pk_bf16(v0[0], v0[1]); w.y = cvt_pk_bf16(v0[2], v0[3]); w.z = cvt_pk_bf16(v1[0], v1[1]); w.w = cvt_pk_bf16(v1[2], v1[3]);
                    *(u32x4*)(rowp + bj * HALF) = w; } }
    }
};
struct EpiIn {
    static constexpr bool PERM = true, AFTER_DRAIN = false;
    bf16_t* Z; LAS const float* bfor; const float* rstd;
    __device__ __forceinline__ void operator()(const f32x4 (&acc)[2][2][4][2], const Unit& u, int wr, int wc, int fr, int fq) const {
        const int row0 = u.pm * BM + wr * 64 + fr + META * ((u.pm >> 5) + 1);
        if (u.pn < 24) {
            const int kind = u.pn >> 2; bf16_t* base = Z + (size_t)kind * (SLOT / 2); const int col0 = (u.pn & 3) * BM + wc * 32 + 8 * fq;
#pragma unroll
            for (int ai = 0; ai < 2; ++ai)
#pragma unroll
                for (int m = 0; m < 4; ++m) { bf16_t* rowp = base + (size_t)(row0 + ai * HALF + m * 16) * DM + col0;
                    const float rs = rstd[u.pm * BM + wr * 64 + fr + ai * HALF + m * 16];
#pragma unroll
                    for (int bj = 0; bj < 2; ++bj) { f32x4 v0 = acc[ai][bj][m][0] * rs, v1 = acc[ai][bj][m][1] * rs;
                        if (kind == 1) { v0 = v0 * C2; v1 = v1 * C2; }
                        else if (kind >= 4) {
#pragma unroll
                            for (int i = 0; i < 4; ++i) { v0[i] = sigmoidf_(v0[i]); v1[i] = sigmoidf_(v1[i]); } }
                        u32x4 w; w.x = cvt_pk_bf16(v0[0], v0[1]); w.y = cvt_pk_bf16(v0[2], v0[3]); w.z = cvt_pk_bf16(v1[0], v1[1]); w.w = cvt_pk_bf16(v1[2], v1[3]);
                        *(u32x4*)(rowp + bj * HALF) = w; } }
        } else if (wc == 0 && fq < 2) {
#pragma unroll
            for (int n = 0; n < 2; ++n)
#pragma unroll
                for (int i = 0; i < 4; ++i) { const int col = 8 * fq + 4 * n + i; const float bb = bfor[col];
#pragma unroll
                    for (int ai = 0; ai < 2; ++ai)
#pragma unroll
                        for (int m = 0; m < 4; ++m) { const int row = row0 + ai * HALF + m * 16; const float x = acc[ai][0][m][n][i] * rstd[u.pm * BM + wr * 64 + fr + ai * HALF + m * 16] + bb;
                            const float ls = fminf(x, 0.f) - __logf(1.0f + __expf(-fabsf(x)));
                            ((float*)((unsigned char*)Z - (WS_Z - WS_LOGF)))[(size_t)col * MP + row] = ls; } }
        }
    }
};
struct EpiSwiglu {
    static constexpr bool PERM = true, AFTER_DRAIN = false;
    bf16_t* O; const float* rstd;
    __device__ __forceinline__ void operator()(const f32x4 (&acc)[2][2][4][2], const Unit& u, int wr, int wc, int fr, int fq) const {
        const int row0 = u.pm * BM + wr * 64 + fr; const int col0 = u.pn * HALF + wc * 32 + 8 * fq;
#pragma unroll
        for (int ai = 0; ai < 2; ++ai)
#pragma unroll
            for (int m = 0; m < 4; ++m) { bf16_t* rowp = O + (size_t)(row0 + ai * HALF + m * 16) * DFF + col0;
                f32x4 r0, r1; const float rs = rstd[row0 + ai * HALF + m * 16];
#pragma unroll
                for (int i = 0; i < 4; ++i) { const float g0 = acc[ai][0][m][0][i] * rs, g1 = acc[ai][0][m][1][i] * rs;
                    r0[i] = g0 * sigmoidf_(g0) * (acc[ai][1][m][0][i] * rs); r1[i] = g1 * sigmoidf_(g1) * (acc[ai][1][m][1][i] * rs); }
                u32x4 w; w.x = cvt_pk_bf16(r0[0], r0[1]); w.y = cvt_pk_bf16(r0[2], r0[3]); w.z = cvt_pk_bf16(r1[0], r1[1]); w.w = cvt_pk_bf16(r1[2], r1[3]);
                *(u32x4*)rowp = w; }
    }
};

template <class Epi, class Sched, bool ALIGN_EPI = false>
__device__ __forceinline__ void gemm_phase(LAS unsigned char* lds, const Gemm g, const Sched& S, const Epi& E) {
    const int tid = tid_opaque(), wid = __builtin_amdgcn_readfirstlane(tid >> 6), lane = tid & 63, wr = wid >> 2, wc = wid & 3, fr = lane & 15, fq = lane >> 4;
    const int K = g.K, nt = K / BK;
    unsigned voffA[2], voffB[2];
#pragma unroll
    for (int i = 0; i < 2; ++i) { int R, C; stage_rc(tid * 16 + i * 8192, R, C); const int Rb = Epi::PERM ? ((R & ~31) + perm32(R & 31)) : R;
        voffA[i] = (unsigned)(R * K + C) * 2u; voffB[i] = (unsigned)(Rb * K + C) * 2u; }
    const size_t kstep = (size_t)(BK * 2);
    const size_t hstep = (size_t)HALF * K * 2;
    const size_t tstep = 2 * hstep;
    const unsigned ldsw = (unsigned)wid * 1024u;
    const int aoff = lds_byte(wr * 64 + fr, fq * 8), boff = lds_byte(wc * 32 + fr, fq * 8);
#define PG8_SA(b, h) (((b) * 2 + (h)) * HTB)
#define PG8_SB(b, h) ((4 + (b) * 2 + (h)) * HTB)
#define PG8_STAGE(bufoff, gbase, voff) do { _Pragma("unroll") for (int _i = 0; _i < 2; ++_i) \
        __builtin_amdgcn_global_load_lds((const unsigned*)((const char*)(gbase) + (voff)[_i]), (LAS unsigned*)(lds + (bufoff) + ldsw + _i * 8192), 16, 0, 0); } while (0)
#define PG8_LDA(dst, b, h) do { _Pragma("unroll") for (int m = 0; m < 4; ++m) _Pragma("unroll") for (int k = 0; k < 2; ++k) dst[m][k] = *(const LAS bf16x8*)(lds + PG8_SA(b, h) + aoff + m * 2048 + k * 1024); } while (0)
#define PG8_LDB(dst, b, h) do { _Pragma("unroll") for (int n = 0; n < 2; ++n) _Pragma("unroll") for (int k = 0; k < 2; ++k) dst[n][k] = *(const LAS bf16x8*)(lds + PG8_SB(b, h) + boff + n * 2048 + k * 1024); } while (0)
#define PG8_MMA(ai, bj, At, Bt) do { __builtin_amdgcn_s_setprio(1); _Pragma("unroll") for (int m = 0; m < 4; ++m) _Pragma("unroll") for (int n = 0; n < 2; ++n) _Pragma("unroll") for (int k = 0; k < 2; ++k) \
        acc[ai][bj][m][n] = __builtin_amdgcn_mfma_f32_16x16x32_bf16(Bt[n][k], At[m][k], acc[ai][bj][m][n], 0, 0, 0); __builtin_amdgcn_s_setprio(0); } while (0)
#define PG8_WAIT_V(n) asm volatile("s_waitcnt vmcnt(" #n ")" ::: "memory")
#define PG8_WAIT_L(n) asm volatile("s_waitcnt lgkmcnt(" #n ")" ::: "memory")
#define PG8_BAR __builtin_amdgcn_s_barrier()
#define PG8_SCHED __builtin_amdgcn_sched_barrier(0)
    Unit cur, nxt; int ui = 0;
    if (!S.next(0, cur)) return;
    f32x4 acc[2][2][4][2];
    float zf = 0.f; asm volatile("" : "+v"(zf));
#pragma unroll
    for (int a = 0; a < 2; ++a)
#pragma unroll
        for (int b = 0; b < 2; ++b)
#pragma unroll
            for (int m = 0; m < 4; ++m)
#pragma unroll
                for (int n = 0; n < 2; ++n) acc[a][b][m][n] = (f32x4){zf, zf, zf, zf};
    bf16x8 At[4][2], B0[2][2], B1[2][2];
    const char* cA = (const char*)g.A + (size_t)cur.pm * tstep; const char* cB = (const char*)g.Bt + (size_t)cur.pn * tstep;
    S.a_ready(cur);
    PG8_STAGE(PG8_SB(0, 0), cB, voffB); PG8_STAGE(PG8_SB(0, 1), cB + hstep, voffB); PG8_STAGE(PG8_SA(0, 0), cA, voffA); PG8_STAGE(PG8_SA(0, 1), cA + hstep, voffA);
    if (wr == 1) PG8_BAR;
    PG8_WAIT_V(2); PG8_BAR;
    PG8_STAGE(PG8_SB(1, 0), cB + kstep, voffB); PG8_STAGE(PG8_SA(1, 0), cA + kstep, voffA); PG8_STAGE(PG8_SB(1, 1), cB + hstep + kstep, voffB);
    PG8_WAIT_V(6); PG8_BAR;
    for (;;) {
        const bool has_next = S.next(ui + 1, nxt);
        const char* nA = has_next ? (const char*)g.A + (size_t)nxt.pm * tstep : cA; const char* nB = has_next ? (const char*)g.Bt + (size_t)nxt.pn * tstep : cB;
        for (int t = 0; t < nt; t += 2) {
            const bool last = (t == nt - 2);
            const char* a1 = cA + (size_t)(t + 1) * kstep;
            const char* a2 = last ? nA : cA + (size_t)(t + 2) * kstep; const char* b2 = last ? nB : cB + (size_t)(t + 2) * kstep;
            const char* a3 = a2 + kstep; const char* b3 = b2 + kstep;
            if (last && has_next) S.a_ready(nxt);
            PG8_LDB(B0, 0, 0); PG8_LDB(B1, 0, 1); PG8_SCHED; PG8_LDA(At, 0, 0); PG8_STAGE(PG8_SA(1, 1), a1 + hstep, voffA);
            PG8_WAIT_V(8); PG8_WAIT_L(0); PG8_BAR; PG8_MMA(0, 0, At, B0); PG8_MMA(0, 1, At, B1); PG8_BAR; PG8_SCHED;
            PG8_LDA(At, 0, 1); PG8_STAGE(PG8_SB(0, 0), b2, voffB); PG8_STAGE(PG8_SB(0, 1), b2 + hstep, voffB); PG8_STAGE(PG8_SA(0, 0), a2, voffA);
            PG8_WAIT_V(8); PG8_WAIT_L(0); PG8_BAR; PG8_MMA(1, 0, At, B0); PG8_MMA(1, 1, At, B1); PG8_BAR; PG8_SCHED;
            PG8_LDB(B0, 1, 0); PG8_LDB(B1, 1, 1); PG8_SCHED; PG8_LDA(At, 1, 0); PG8_STAGE(PG8_SA(0, 1), a2 + hstep, voffA);
            PG8_WAIT_V(8); PG8_WAIT_L(0); PG8_BAR; PG8_MMA(0, 0, At, B0); PG8_MMA(0, 1, At, B1); PG8_BAR; PG8_SCHED;
            PG8_LDA(At, 1, 1); PG8_STAGE(PG8_SB(1, 0), b3, voffB); PG8_STAGE(PG8_SB(1, 1), b3 + hstep, voffB); PG8_STAGE(PG8_SA(1, 0), a3, voffA);
            PG8_WAIT_V(8); PG8_WAIT_L(0); PG8_BAR; PG8_MMA(1, 0, At, B0); PG8_MMA(1, 1, At, B1); PG8_BAR; PG8_SCHED;
        }
        if constexpr (ALIGN_EPI) { if (wr == 0) PG8_BAR; }
        E(acc, cur, wr, wc, fr, fq); S.done(cur);
        if (!has_next) break;
#pragma unroll
        for (int a = 0; a < 2; ++a)
#pragma unroll
            for (int b = 0; b < 2; ++b)
#pragma unroll
                for (int m = 0; m < 4; ++m)
#pragma unroll
                    for (int n = 0; n < 2; ++n) acc[a][b][m][n] = (f32x4){zf, zf, zf, zf};
        cur = nxt; cA = nA; cB = nB; ++ui;
        if constexpr (ALIGN_EPI) { if (wr == 1) PG8_BAR; }
    }
    PG8_WAIT_V(0);
    if constexpr (!ALIGN_EPI) { if (wr == 0) PG8_BAR; }
    PG8_BAR;
#undef PG8_SA
#undef PG8_SB
#undef PG8_STAGE
#undef PG8_LDA
#undef PG8_LDB
#undef PG8_MMA
#undef PG8_WAIT_V
#undef PG8_WAIT_L
#undef PG8_BAR
#undef PG8_SCHED
}
}

__device__ __forceinline__ unsigned f2bf(float f) { unsigned u = __builtin_bit_cast(unsigned, f); return (u + 0x7fffu + ((u >> 16) & 1u)) >> 16; }
__device__ __forceinline__ unsigned pk2(float lo, float hi) { f32x2 v = {lo, hi}; bf16x2_t b = __builtin_convertvector(v, bf16x2_t); return __builtin_bit_cast(unsigned, b); }
__device__ __forceinline__ float bf_lo(unsigned w) { return __builtin_bit_cast(float, w << 16); }
__device__ __forceinline__ float bf_hi(unsigned w) { return __builtin_bit_cast(float, w & 0xffff0000u); }
__device__ __forceinline__ float wave_sum(float v) {
#pragma unroll
    for (int o = 1; o < 64; o <<= 1) v += __shfl_xor(v, o);
    return v;
}
__device__ __forceinline__ unsigned cvtpk_s(float lo, float hi) { f32x2 v = {lo, hi}; bf16x2_t b = __builtin_convertvector(v, bf16x2_t); return __builtin_bit_cast(unsigned, b); }

struct Params {
    const float* x; const float* meta; const float* n_mix_pre; const float* n_mix_post; const float* n_ffn_pre; const float* n_ffn_post;
    const float* w_in; const float* b_forget; const float* w_pool; const float* pool_scale; const float* w_out; const float* w_gate; const float* w_up; const float* w_down;
    float* out; unsigned char* ws;
};
typedef const __attribute__((address_space(4))) Params* KP;
__device__ __forceinline__ KP params_opaque() { KP q = (KP)__builtin_amdgcn_kernarg_segment_ptr(); asm volatile("" : "+s"(q)); return q; }


namespace sk {
struct EpiInM {
    bf16_t* Z; LAS const float* bfor; const float* rstd;
    static constexpr int NBB = 1;
    __device__ __forceinline__ int nunits() const { return 6144 / 16 + 1; }
    __device__ __forceinline__ int brow(int u, int nb) const { return 16 * u; }
    __device__ __forceinline__ void operator()(const f32x4 (&a)[1], int u, int rb, int fr, int fq) const {
        const int n0 = 16 * u; const size_t nrow = (size_t)rb * TT + fr;
        const float rs = rstd[MM + 16 * rb + fr];
        if (n0 < 6144) { const int kind = n0 >> 10; f32x4 v = a[0] * rs;
            if (kind == 1) v = v * C2; else if (kind >= 4) { v[0] = pg8::sigmoidf_(v[0]); v[1] = pg8::sigmoidf_(v[1]); v[2] = pg8::sigmoidf_(v[2]); v[3] = pg8::sigmoidf_(v[3]); }
            *(u32x2*)(Z + (size_t)kind * (SLOT / 2) + nrow * DM + (n0 & 1023) + 4 * fq) = (u32x2){pg8::cvt_pk_bf16(v[0], v[1]), pg8::cvt_pk_bf16(v[2], v[3])};
        } else {
#pragma unroll
            for (int i = 0; i < 4; ++i) { const int col = 4 * fq + i; const float x = a[0][i] * rs + bfor[col]; const float ls = fminf(x, 0.f) - __logf(1.0f + __expf(-fabsf(x)));
                ((float*)((unsigned char*)Z - (WS_Z - WS_LOGF)))[(size_t)col * MP + nrow] = ls; }
        }
    }
};
struct EpiPlainM {
    bf16_t* O;
    static constexpr int NBB = 1;
    __device__ __forceinline__ int nunits() const { return DM / 16; }
    __device__ __forceinline__ int brow(int u, int nb) const { return 16 * u; }
    __device__ __forceinline__ void operator()(const f32x4 (&a)[1], int u, int rb, int fr, int fq) const {
        *(u32x2*)(O + (size_t)(MM + 16 * rb + fr) * DM + 16 * u + 4 * fq) = (u32x2){pg8::cvt_pk_bf16(a[0][0], a[0][1]), pg8::cvt_pk_bf16(a[0][2], a[0][3])};
    }
};
struct EpiSwigluM {
    bf16_t* O; const float* rstd;
    static constexpr int NBB = 2;
    __device__ __forceinline__ int nunits() const { return DFF / 16; }
    __device__ __forceinline__ int brow(int u, int nb) const { const int ch = 16 * u; return (ch >> 7) * 256 + nb * 128 + (ch & 127); }
    __device__ __forceinline__ void operator()(const f32x4 (&a)[2], int u, int rb, int fr, int fq) const {
        f32x4 r;
        const float rs = rstd[MM + 16 * rb + fr];
#pragma unroll
        for (int i = 0; i < 4; ++i) { const float g = a[0][i] * rs; r[i] = g * pg8::sigmoidf_(g) * (a[1][i] * rs); }
        *(u32x2*)(O + (size_t)(MM + 16 * rb + fr) * DFF + 16 * u + 4 * fq) = (u32x2){pg8::cvt_pk_bf16(r[0], r[1]), pg8::cvt_pk_bf16(r[2], r[3])};
    }
};
template <int K, class Epi>
__device__ __forceinline__ void phase(LAS unsigned char* lds, const bf16_t* A, const bf16_t* Bt, const Epi& E, int ubase, int ustride) {
    if ((int)blockIdx.x < ubase) return;
    constexpr int NBB = Epi::NBB;
    const int tid = tid_opaque(), lane = tid & 63, fr = lane & 15, fq = lane >> 4; const int wave = __builtin_amdgcn_readfirstlane(tid >> 6);
    constexpr int ksteps = K / 256;
    LAS f32x4* red = (LAS f32x4*)lds;
    const int nu = E.nunits();
    for (int u = (int)blockIdx.x - ubase; u < nu; u += ustride) {
        f32x4 acc[NBB][4];
#pragma unroll
        for (int nb = 0; nb < NBB; ++nb)
#pragma unroll
            for (int rb = 0; rb < 4; ++rb) acc[nb][rb] = (f32x4){0.f, 0.f, 0.f, 0.f};
        const bf16_t* ap = A + (size_t)fr * K + wave * ksteps * 32 + 8 * fq;
        const bf16_t* bp0 = Bt + (size_t)(E.brow(u, 0) + fr) * K + wave * ksteps * 32 + 8 * fq;
        const bf16_t* bp1 = Bt + (size_t)(E.brow(u, NBB - 1) + fr) * K + wave * ksteps * 32 + 8 * fq;
#pragma unroll
        for (int st = 0; st < ksteps; ++st) {
            const bf16x8 b0 = *(const bf16x8*)(bp0 + 32 * st); bf16x8 b1; if (NBB == 2) b1 = *(const bf16x8*)(bp1 + 32 * st);
#pragma unroll
            for (int rb = 0; rb < 4; ++rb) { const bf16x8 a = *(const bf16x8*)(ap + (size_t)(16 * rb) * K + 32 * st);
                acc[0][rb] = __builtin_amdgcn_mfma_f32_16x16x32_bf16(b0, a, acc[0][rb], 0, 0, 0);
                if (NBB == 2) acc[NBB - 1][rb] = __builtin_amdgcn_mfma_f32_16x16x32_bf16(b1, a, acc[NBB - 1][rb], 0, 0, 0); }
        }
        __syncthreads();
#pragma unroll
        for (int nb = 0; nb < NBB; ++nb)
#pragma unroll
            for (int rb = 0; rb < 4; ++rb) red[(wave * (NBB * 4) + nb * 4 + rb) * 64 + lane] = acc[nb][rb];
        __syncthreads();
        if (wave < 4) { f32x4 sum[NBB];
#pragma unroll
            for (int nb = 0; nb < NBB; ++nb) { sum[nb] = red[(nb * 4 + wave) * 64 + lane];
#pragma unroll
                for (int w = 1; w < 8; ++w) sum[nb] = sum[nb] + red[(w * (NBB * 4) + nb * 4 + wave) * 64 + lane]; }
            E(sum, u, wave, fr, fq); }
    }
    __syncthreads();
}
}

__device__ __forceinline__ void tr_item(const float* src, int ldw, int nvalid, bf16_t* dst, int ldk, LAS float* scr, int lane, const float* gk = nullptr) {
    { const int kr = lane >> 3, n4 = 4 * (lane & 7);
      f32x4 v[8];
#pragma unroll
      for (int i = 0; i < 8; ++i) { const int kk = 8 * i + kr; v[i] = (n4 < nvalid) ? *(const f32x4*)(src + (size_t)kk * ldw + n4) : (f32x4){0.f, 0.f, 0.f, 0.f}; }
#pragma unroll
      for (int i = 0; i < 8; ++i) { const int kk = 8 * i + kr; const float gsc = gk ? gk[kk] : 1.0f; LAS float* d = scr + kk * 33 + n4;
          d[0] = v[i].x * gsc; d[1] = v[i].y * gsc; d[2] = v[i].z * gsc; d[3] = v[i].w * gsc; } }
    asm volatile("s_waitcnt lgkmcnt(0)" ::: "memory");
    const int c = lane & 7;
#pragma unroll
    for (int j = 0; j < 4; ++j) { const int n = (lane >> 3) + 8 * j; const LAS float* s = scr + (8 * c) * 33 + n;
        u32x4 o; o.x = pk2(s[0 * 33], s[1 * 33]); o.y = pk2(s[2 * 33], s[3 * 33]); o.z = pk2(s[4 * 33], s[5 * 33]); o.w = pk2(s[6 * 33], s[7 * 33]);
        *(u32x4*)(dst + (size_t)n * ldk + 8 * c) = o; }
    asm volatile("s_waitcnt lgkmcnt(0)" ::: "memory");
}

constexpr int CV_SEG = 16 * 32, CV_F = 16, CV_FF = 16 * 88, CV_DN = 44 * 32;
constexpr int CV_Z = 256, CV_IN8 = (5 * CV_SEG + CV_F) / 8, CV_REST8 = (CV_SEG + 2 * CV_FF + CV_DN) / 8;
static_assert(CV_IN8 * 8 == 5 * CV_SEG + CV_F && CV_REST8 * 8 == CV_SEG + 2 * CV_FF + CV_DN, "wave items per workgroup item");
__device__ __forceinline__ void conv_z_item(KP p, int l, int item, LAS unsigned char* lds) {
    const int tid = tid_opaque(), lane = tid & 63, fr = lane & 15, fq = lane >> 4; const int wave = __builtin_amdgcn_readfirstlane(tid >> 6);
    bf16_t* Wt_in = (bf16_t*)(p->ws + WS_WIN); const float* w_in = p->w_in + (size_t)l * DM * NIN_SRC;
    const int g = item >> 6, kb = (item >> 2) & 15, db = item & 3, k0 = kb * 64 + 32 * (wave >> 2), d0 = db * 64 + 16 * (wave & 3);
    const float* wp = p->w_pool + ((size_t)(l * 4 + g) * 256) * 256 + d0 + fr;
    const float* y0 = w_in + (size_t)(k0 + fr) * NIN_SRC + g * 256 + 8 * fq;
    const float* y1 = y0 + (size_t)16 * NIN_SRC;
    const float g0 = p->n_mix_pre[l * DM + k0 + fr], g1 = p->n_mix_pre[l * DM + k0 + 16 + fr];
    f32x4 acc0 = (f32x4){0.f, 0.f, 0.f, 0.f}, acc1 = acc0;
#pragma unroll 4
    for (int st = 0; st < 8; ++st) {
        const int c0 = 32 * st;
        float xf[8];
#pragma unroll
        for (int i = 0; i < 8; ++i) xf[i] = wp[(size_t)(c0 + 8 * fq + i) * 256];
        const f32x4 a0 = *(const f32x4*)(y0 + c0), a1 = *(const f32x4*)(y0 + c0 + 4), b0 = *(const f32x4*)(y1 + c0), b1 = *(const f32x4*)(y1 + c0 + 4);
        const u32x4 xw = (u32x4){cvtpk_s(xf[0], xf[1]), cvtpk_s(xf[2], xf[3]), cvtpk_s(xf[4], xf[5]), cvtpk_s(xf[6], xf[7])};
        const u32x4 yw0 = (u32x4){cvtpk_s(a0.x * g0, a0.y * g0), cvtpk_s(a0.z * g0, a0.w * g0), cvtpk_s(a1.x * g0, a1.y * g0), cvtpk_s(a1.z * g0, a1.w * g0)};
        const u32x4 yw1 = (u32x4){cvtpk_s(b0.x * g1, b0.y * g1), cvtpk_s(b0.z * g1, b0.w * g1), cvtpk_s(b1.x * g1, b1.y * g1), cvtpk_s(b1.z * g1, b1.w * g1)};
        acc0 = __builtin_amdgcn_mfma_f32_16x16x32_bf16(__builtin_bit_cast(bf16x8, xw), __builtin_bit_cast(bf16x8, yw0), acc0, 0, 0, 0);
        acc1 = __builtin_amdgcn_mfma_f32_16x16x32_bf16(__builtin_bit_cast(bf16x8, xw), __builtin_bit_cast(bf16x8, yw1), acc1, 0, 0, 0);
    }
#pragma unroll
    for (int i = 0; i < 4; ++i) { bf16_t* o = Wt_in + (size_t)(g * 256 + d0 + 4 * fq + i) * DM + k0 + fr;
        o[0] = (bf16_t)f2bf(acc0[i]); o[16] = (bf16_t)f2bf(acc1[i]); }
}
__device__ __forceinline__ void conv_tr_in(KP p, int l, int r, LAS float* scr, int lane) {
    bf16_t* Wt_in = (bf16_t*)(p->ws + WS_WIN); const float* w_in = p->w_in + (size_t)l * DM * NIN_SRC;
    if (r < 5 * CV_SEG) { const int seg = r / CV_SEG; r -= seg * CV_SEG; const int kb = r >> 5, nb = r & 31;
        const int srccol = (seg < 3 ? 1024 * (seg + 1) : 4112 + 1024 * (seg - 3)) + 32 * nb;
        tr_item(w_in + (size_t)(64 * kb) * NIN_SRC + srccol, NIN_SRC, 32, Wt_in + (size_t)(1024 * (seg + 1) + 32 * nb) * DM + 64 * kb, DM, scr, lane, p->n_mix_pre + l * DM + 64 * kb);
    } else { r -= 5 * CV_SEG; tr_item(w_in + (size_t)(64 * r) * NIN_SRC + 4096, NIN_SRC, 16, Wt_in + (size_t)6144 * DM + 64 * r, DM, scr, lane, p->n_mix_pre + l * DM + 64 * r); }
}
__device__ __forceinline__ void conv_tr_rest(KP p, int l, int r, LAS float* scr, int lane) {
    bf16_t* Wt_out = (bf16_t*)(p->ws + WS_WOUT); bf16_t* Wt_gu = (bf16_t*)(p->ws + WS_WGU); bf16_t* Wt_dn = (bf16_t*)(p->ws + WS_WDN);
    if (r < CV_SEG) { const int kb = r >> 5, nb = r & 31;
        tr_item(p->w_out + (size_t)l * DM * DM + (size_t)(64 * kb) * DM + 32 * nb, DM, 32, Wt_out + (size_t)(32 * nb) * DM + 64 * kb, DM, scr, lane);
    } else if (r < CV_SEG + 2 * CV_FF) { r -= CV_SEG; const int up = r >= CV_FF; if (up) r -= CV_FF; const int kb = r / 88, nb = r % 88; const int n0 = 32 * nb;
        const float* W = (up ? p->w_up : p->w_gate) + (size_t)l * DM * DFF;
        const int drow = (n0 >> 7) * 256 + (up ? 128 : 0) + (n0 & 127);
        tr_item(W + (size_t)(64 * kb) * DFF + n0, DFF, 32, Wt_gu + (size_t)drow * DM + 64 * kb, DM, scr, lane, p->n_ffn_pre + l * DM + 64 * kb);
    } else { r -= CV_SEG + 2 * CV_FF; const int kb = r >> 5, nb = r & 31;
        tr_item(p->w_down + (size_t)l * DFF * DM + (size_t)(64 * kb) * DM + 32 * nb, DM, 32, Wt_dn + (size_t)(32 * nb) * DFF + 64 * kb, DFF, scr, lane); }
}
__device__ __forceinline__ int conv_count(int l_in, bool rest) { return (l_in < DEPTH ? CV_Z + CV_IN8 : 0) + (rest ? CV_REST8 : 0); }
__device__ __forceinline__ void conv_wg_item(KP p, int l_in, int l_rest, int ci, LAS unsigned char* lds) {
    const int tid = tid_opaque(), lane = tid & 63, wave = tid >> 6;
    LAS float* scr = (LAS float*)(lds + wave * 16384);
    const int nin = (l_in < DEPTH) ? CV_Z + CV_IN8 : 0;
    if (ci < nin) { if (ci < CV_Z) conv_z_item(p, l_in, ci, lds); else conv_tr_in(p, l_in, (ci - CV_Z) * 8 + wave, scr, lane); }
    else conv_tr_rest(p, l_rest, (ci - nin) * 8 + wave, scr, lane);
    __syncthreads();
}

template <int MODE, bool DRY = false>
__device__ __forceinline__ void norm_pass(KP p, const float* g_post) {
    const int tid_ = tid_opaque(); const int lane = tid_ & 63, wave = tid_ >> 6;
    const int gw = blockIdx.x * 8 + wave, NGW = gridDim.x * 8;
    const bf16_t* mix = (const bf16_t*)(p->ws + WS_MIX); bf16_t* X = (bf16_t*)(p->ws + WS_HB); float* rstdA = (float*)(p->ws + WS_RSTD) + (DRY ? 65536 : 0);
    bf16_t* Xw = DRY ? (bf16_t*)(p->ws + WS_Z) : X;
    constexpr int RB = 4;
    f32x4 gpo[4];
#pragma unroll
    for (int j = 0; j < 4; ++j) gpo[j] = (MODE != 0) ? ((const f32x4*)g_post)[lane + 64 * j] : (f32x4){0.f, 0.f, 0.f, 0.f};
    for (int r0 = gw; r0 < MREAL; r0 += RB * NGW) {
        f32x4 v[RB][4]; u32x2 mw[RB][4], xw[RB][4]; bool ok[RB]; int cr[RB], bb[RB], tt[RB];
#pragma unroll
        for (int i = 0; i < RB; ++i) { const int r = r0 + i * NGW; ok[i] = r < MREAL; const int rr = ok[i] ? r : r0; bb[i] = rr / TT; tt[i] = rr - bb[i] * TT; cr[i] = compact_row(bb[i], tt[i]);
            if (MODE == 0) { const float* src = tt[i] < META ? p->meta + (size_t)tt[i] * DM : p->x + ((size_t)bb[i] * SEQ + (tt[i] - META)) * DM;
#pragma unroll
                for (int j = 0; j < 4; ++j) v[i][j] = ((const f32x4*)src)[lane + 64 * j];
            } else { const u32x2* mr = (const u32x2*)(mix + (size_t)cr[i] * DM); const u32x2* xr = (const u32x2*)(X + (size_t)cr[i] * DM);
#pragma unroll
                for (int j = 0; j < 4; ++j) { mw[i][j] = mr[lane + 64 * j]; xw[i][j] = xr[lane + 64 * j]; } } }
        if (MODE != 0) {
            float ss[RB];
#pragma unroll
            for (int i = 0; i < RB; ++i) { ss[i] = 0.f;
#pragma unroll
                for (int j = 0; j < 4; ++j) { const float a = bf_lo(mw[i][j].x), b = bf_hi(mw[i][j].x), c = bf_lo(mw[i][j].y), d = bf_hi(mw[i][j].y); ss[i] += (a * a + b * b) + (c * c + d * d); } }
#pragma unroll
            for (int o = 1; o < 64; o <<= 1) {
#pragma unroll
                for (int i = 0; i < RB; ++i) ss[i] += __shfl_xor(ss[i], o); }
#pragma unroll
            for (int i = 0; i < RB; ++i) { const float rstd = 1.0f / sqrtf(ss[i] * (1.0f / DM) + RMS_EPS);
#pragma unroll
                for (int j = 0; j < 4; ++j) { const f32x4 mx = (f32x4){bf_lo(mw[i][j].x), bf_hi(mw[i][j].x), bf_lo(mw[i][j].y), bf_hi(mw[i][j].y)};
                    const f32x4 xo = (f32x4){bf_lo(xw[i][j].x), bf_hi(xw[i][j].x), bf_lo(xw[i][j].y), bf_hi(xw[i][j].y)}; v[i][j] = xo + mx * rstd * gpo[j]; } }
        }
        if (MODE == 2) {
#pragma unroll
            for (int i = 0; i < RB; ++i) { if (ok[i] && tt[i] >= META) { f32x4* o = (f32x4*)(p->out + ((size_t)bb[i] * SEQ + (tt[i] - META)) * DM);
#pragma unroll
                for (int j = 0; j < 4; ++j) o[lane + 64 * j] = v[i][j]; } }
        } else {
            float s2[RB];
#pragma unroll
            for (int i = 0; i < RB; ++i) { s2[i] = 0.f; u32x2* o = (u32x2*)(Xw + (size_t)cr[i] * DM);
#pragma unroll
                for (int j = 0; j < 4; ++j) { const u32x2 w = (u32x2){pk2(v[i][j].x, v[i][j].y), pk2(v[i][j].z, v[i][j].w)};
                    const float a = bf_lo(w.x), b = bf_hi(w.x), c = bf_lo(w.y), d = bf_hi(w.y); s2[i] += (a * a + b * b) + (c * c + d * d);
                    if (ok[i]) o[lane + 64 * j] = w; } }
#pragma unroll
            for (int o = 1; o < 64; o <<= 1) {
#pragma unroll
                for (int i = 0; i < RB; ++i) s2[i] += __shfl_xor(s2[i], o); }
#pragma unroll
            for (int i = 0; i < RB; ++i) { if (ok[i] && lane == 0) rstdA[cr[i]] = 1.0f / sqrtf(s2[i] * (1.0f / DM) + RMS_EPS); }
        }
    }
}

__device__ __forceinline__ void scan_unit(KP p, int bh, LAS unsigned char* lds) {
    const int tid = tid_opaque(), lane = tid & 63, wave = tid >> 6;
    const int b = bh >> 4, h = bh & 15;
    const float* src = (const float*)(p->ws + WS_LOGF) + (size_t)h * MP + (size_t)b * TT;
    float* dst = (float*)(p->ws + WS_FB) + (size_t)bh * TT;
    LAS float* wt = (LAS float*)lds;
    const int t0 = tid * 17;
    float v[17]; float s = 0.f;
#pragma unroll
    for (int i = 0; i < 17; ++i) { const int t = t0 + i; v[i] = (t < TT) ? src[t] : 0.f; s += v[i]; }
    float inc = s;
#pragma unroll
    for (int o = 1; o < 64; o <<= 1) { const float n = __shfl_up(inc, o); if (lane >= o) inc += n; }
    __syncthreads();
    if (lane == 63) wt[wave] = inc;
    __syncthreads();
    float pre = inc - s;
#pragma unroll
    for (int w = 0; w < 8; ++w) if (w < wave) pre += wt[w];
#pragma unroll
    for (int i = 0; i < 17; ++i) { const int t = t0 + i; pre += v[i]; if (t < TT) dst[t] = -pre * LOG2E; }
    __syncthreads();
}

__device__ __forceinline__ void poolgate_phase(KP p, int l) {
    const int gid = blockIdx.x * 512 + tid_opaque();
    constexpr int RUN = 36, NRUN = TT / RUN;
    static_assert(NRUN * RUN == TT, "runs");
    const bf16_t* Z = (const bf16_t*)(p->ws + WS_Z); const bf16_t* SGP = (const bf16_t*)(p->ws + WS_Z + 4 * SLOT); bf16_t* MRG = (bf16_t*)p->out;
    for (int id = gid; id < NB * NRUN * 128; id += gridDim.x * 512) {
        const int ct = id & 127, rr = id >> 7, b = rr / NRUN, run = rr - b * NRUN;
        const int t0 = run * RUN;
        const int c0 = ct * 8, g = c0 >> 8, w = 2 << g;
        const bf16_t* Zc = Z + (size_t)b * TT * DM + c0; const bf16_t* Gc = SGP + (size_t)b * TT * DM + c0; bf16_t* Mc = MRG + c0;
        float sc[8];
        { const f32x4 a = *(const f32x4*)(p->pool_scale + (size_t)l * DM + c0), bq = *(const f32x4*)(p->pool_scale + (size_t)l * DM + c0 + 4);
          sc[0] = a.x; sc[1] = a.y; sc[2] = a.z; sc[3] = a.w; sc[4] = bq.x; sc[5] = bq.y; sc[6] = bq.z; sc[7] = bq.w; }
        float sum[8];
#pragma unroll
        for (int i = 0; i < 8; ++i) sum[i] = 0.f;
#define PG_ACC(S_, zv) do { sum[0] S_ bf_lo(zv.x); sum[1] S_ bf_hi(zv.x); sum[2] S_ bf_lo(zv.y); sum[3] S_ bf_hi(zv.y); sum[4] S_ bf_lo(zv.z); sum[5] S_ bf_hi(zv.z); sum[6] S_ bf_lo(zv.w); sum[7] S_ bf_hi(zv.w); } while (0)
        { u32x4 hz[15];
#pragma unroll
          for (int i = 0; i < 15; ++i) { const int t = t0 - 15 + i; hz[i] = *(const u32x4*)(Zc + (size_t)(t > 0 ? t : 0) * DM); }
#pragma unroll
          for (int i = 0; i < 15; ++i) { const int t = t0 - 15 + i; if (t >= 0 && t > t0 - w) PG_ACC(+=, hz[i]); } }
        for (int tb = t0; tb < t0 + RUN; tb += 4) {
            u32x4 zv[4], gv[4], zo[4];
#pragma unroll
            for (int i = 0; i < 4; ++i) { const int t = tb + i; const int tl = t - w + 1;
                zv[i] = *(const u32x4*)(Zc + (size_t)t * DM); gv[i] = *(const u32x4*)(Gc + (size_t)t * DM); zo[i] = *(const u32x4*)(Zc + (size_t)(tl > 0 ? tl : 0) * DM); }
#pragma unroll
            for (int i = 0; i < 4; ++i) { const int t = tb + i; const int tl = t - w + 1;
                const float zz[8] = {bf_lo(zv[i].x), bf_hi(zv[i].x), bf_lo(zv[i].y), bf_hi(zv[i].y), bf_lo(zv[i].z), bf_hi(zv[i].z), bf_lo(zv[i].w), bf_hi(zv[i].w)};
                const float gg[8] = {bf_lo(gv[i].x), bf_hi(gv[i].x), bf_lo(gv[i].y), bf_hi(gv[i].y), bf_lo(gv[i].z), bf_hi(gv[i].z), bf_lo(gv[i].w), bf_hi(gv[i].w)};
                const float inv = 1.0f / (float)((t + 1 < w) ? t + 1 : w);
                float y[8];
#pragma unroll
                for (int e = 0; e < 8; ++e) { sum[e] += zz[e]; y[e] = (sum[e] * inv - zz[e]) * sc[e] * gg[e]; }
                u32x4 o; o.x = pk2(y[0], y[1]); o.y = pk2(y[2], y[3]); o.z = pk2(y[4], y[5]); o.w = pk2(y[6], y[7]);
                *(u32x4*)(Mc + (size_t)compact_row(b, t) * DM) = o;
                if (tl >= 0) PG_ACC(-=, zo[i]); }
        }
#undef PG_ACC
    }
}

constexpr int CW_NORM = 512;
__device__ __forceinline__ void qknorm_phase(KP p, int l, LAS unsigned char* lds) {
    const int tid = tid_opaque(), lane = tid & 63, wave = tid >> 6;
    LAS unsigned* tab = (LAS unsigned*)(lds + 1024);
    if (tid < 64) tab[tid] = 0u;
    __syncthreads();
    const bf16_t* Qg = (const bf16_t*)(p->ws + WS_Z + 1 * SLOT); const bf16_t* Kg = (const bf16_t*)(p->ws + WS_Z + 2 * SLOT);
    const int r0 = blockIdx.x * 129, r1 = (r0 + 129 < MREAL) ? r0 + 129 : MREAL;
    const int b0 = r0 / TT;
    float mq0 = 0.f, mk0 = 0.f, mq1 = 0.f, mk1 = 0.f;
#define SQ2(w) (bf_lo(w) * bf_lo(w) + bf_hi(w) * bf_hi(w))
    for (int rb_ = r0 + wave; rb_ < r1; rb_ += 32) {
        u32x4 qa[4], qb[4], ka[4], kb[4];
#pragma unroll
        for (int i = 0; i < 4; ++i) { const int r = (rb_ + 8 * i < r1) ? rb_ + 8 * i : rb_;
            const u32x4* qp = (const u32x4*)(Qg + (size_t)r * DM) + 2 * lane; const u32x4* kp = (const u32x4*)(Kg + (size_t)r * DM) + 2 * lane;
            qa[i] = qp[0]; qb[i] = qp[1]; ka[i] = kp[0]; kb[i] = kp[1]; }
#pragma unroll
        for (int i = 0; i < 4; ++i) { const int r = rb_ + 8 * i;
            float sq = (SQ2(qa[i].x) + SQ2(qa[i].y)) + (SQ2(qa[i].z) + SQ2(qa[i].w)) + (SQ2(qb[i].x) + SQ2(qb[i].y)) + (SQ2(qb[i].z) + SQ2(qb[i].w));
            float sk = (SQ2(ka[i].x) + SQ2(ka[i].y)) + (SQ2(ka[i].z) + SQ2(ka[i].w)) + (SQ2(kb[i].x) + SQ2(kb[i].y)) + (SQ2(kb[i].z) + SQ2(kb[i].w));
            sq += __shfl_xor(sq, 1); sq += __shfl_xor(sq, 2); sk += __shfl_xor(sk, 1); sk += __shfl_xor(sk, 2);
            if (r < r1) { if (r / TT == b0) { mq0 = fmaxf(mq0, sq); mk0 = fmaxf(mk0, sk); } else { mq1 = fmaxf(mq1, sq); mk1 = fmaxf(mk1, sk); } } }
    }
#undef SQ2
    if ((lane & 3) == 0) { const int h = lane >> 2;
        __hip_atomic_fetch_max(tab + h, __builtin_bit_cast(unsigned, mq0), __ATOMIC_RELAXED, __HIP_MEMORY_SCOPE_WORKGROUP);
        __hip_atomic_fetch_max(tab + 16 + h, __builtin_bit_cast(unsigned, mk0), __ATOMIC_RELAXED, __HIP_MEMORY_SCOPE_WORKGROUP);
        __hip_atomic_fetch_max(tab + 32 + h, __builtin_bit_cast(unsigned, mq1), __ATOMIC_RELAXED, __HIP_MEMORY_SCOPE_WORKGROUP);
        __hip_atomic_fetch_max(tab + 48 + h, __builtin_bit_cast(unsigned, mk1), __ATOMIC_RELAXED, __HIP_MEMORY_SCOPE_WORKGROUP); }
    __syncthreads();
    if (tid < 64) { const int b = b0 + (tid >> 5); const unsigned v = tab[tid];
        if (b < NB && v != 0u) __hip_atomic_fetch_max((unsigned*)(p->ws + WS_CTL) + CW_NORM + ((l * NB + b) * 2 + ((tid >> 4) & 1)) * NH + (tid & 15), v, __ATOMIC_RELAXED, __HIP_MEMORY_SCOPE_AGENT); }
    __syncthreads();
}

namespace att {
constexpr int L_B = 32768, L_WS = 33280, L_OST = 36864, L_Q = 69632;
__device__ __forceinline__ int crow(int r, int hi) { return (r & 3) + 8 * (r >> 2) + 4 * hi; }
__device__ __forceinline__ float max3f(float a, float b, float c) { float r; asm("v_max3_f32 %0, %1, %2, %3" : "=v"(r) : "v"(a), "v"(b), "v"(c)); return r; }
__device__ __forceinline__ float max2f(float a, float b) { float r; asm("v_max_f32_e32 %0, %1, %2" : "=v"(r) : "v"(a), "v"(b)); return r; }
typedef short v4i16_t __attribute__((ext_vector_type(4)));
__device__ __forceinline__ s16x4 vtr(const LAS unsigned char* p) { return __builtin_bit_cast(s16x4, __builtin_amdgcn_ds_read_tr16_b64_v4i16((LAS v4i16_t*)p)); }

__device__ __forceinline__ void attn_unit(int b, int h, int q0, int nrows, const bf16_t* Qg, const bf16_t* Kg, const bf16_t* Vg, const bf16_t* SGA, bf16_t* MRG,
                                          const float* FBbh, float skipB, bool dostore, LAS unsigned char* shm) {
    const int tid = tid_opaque(), lane = tid & 63, r32 = lane & 31, hi = lane >> 5; const int wid = __builtin_amdgcn_readfirstlane(tid >> 6);
    const size_t rowbase = (size_t)b * TT;
    const int qw0 = q0 + 32 * wid, lastq = q0 + nrows - 1, NT = lastq / 64 + 1;
    const bool wact = (32 * wid < nrows);
    const int qabs = qw0 + r32;
    bf16x8 qr[4];
    { const int qrow = qabs < TT ? qabs : TT - 1; const bf16_t* qp = Qg + (rowbase + qrow) * DM + h * HD + hi * 8;
#pragma unroll
      for (int d0 = 0; d0 < 4; ++d0) qr[d0] = *(const bf16x8*)(qp + d0 * 16); }
    const bf16_t* ksrc = Kg + (rowbase + lane) * DM + h * HD + wid * 8;
    const bf16_t* vsrc = Vg + (rowbase + 16 * (wid & 3) + (lane >> 2)) * DM + h * HD + (wid >> 2) * 32 + (lane & 3) * 8;
    const unsigned stoff = (unsigned)wid * 1024u + (unsigned)lane * 16u;
    int j0;
    { LAS unsigned* wc = (LAS unsigned*)(shm + L_Q + 64);
      const float limit = FBbh[q0] - skipB;
      bool pred = false;
      if (tid < NT) { const int ke = 64 * tid + 63; pred = FBbh[ke < TT ? ke : TT - 1] < limit; }
      const unsigned long long bal = __ballot(pred);
      if (lane == 0) wc[wid] = (unsigned)__popcll(bal);
      __syncthreads();
      j0 = (int)(wc[0] + wc[1] + wc[2]);
      if (j0 > NT - 1) j0 = NT - 1; }
    u32x4 kreg = *(const u32x4*)(ksrc + (size_t)j0 * 64 * DM), vreg = *(const u32x4*)(vsrc + (size_t)j0 * 64 * DM); float breg = (tid < 64) ? FBbh[j0 * 64 + tid] : 0.f;
    { const int nb0 = (j0 & 1) * 16384; *(LAS u32x4*)(shm + nb0 + stoff) = kreg; *(LAS u32x4*)(shm + nb0 + 8192 + stoff) = vreg; if (tid < 64) ((LAS float*)(shm + L_B + (j0 & 1) * 256))[tid] = breg; }
    if (j0 + 1 < NT) { kreg = *(const u32x4*)(ksrc + (size_t)(j0 + 1) * 64 * DM); vreg = *(const u32x4*)(vsrc + (size_t)(j0 + 1) * 64 * DM); if (tid < 64) breg = FBbh[(j0 + 1) * 64 + tid]; }
    u32x4 kreg2 = kreg, vreg2 = vreg; float breg2 = breg;
    __syncthreads();
    float m = NEGBIG, l = 0.f; f32x16 o0, o1;
#pragma unroll
    for (int r = 0; r < 16; ++r) { o0[r] = 0.f; o1[r] = 0.f; }
    LAS float* wsf = (LAS float*)(shm + L_WS + wid * 256);
    for (int jj = j0; jj < NT; jj += 2) {
#pragma unroll
      for (int half = 0; half < 2; ++half) {
        const int j = jj + half; if (j >= NT) break;
        const int cur = j & 1; const bool more = (j + 1 < NT);
        if (j + 2 < NT) {
            if (half == 0) { kreg2 = *(const u32x4*)(ksrc + (size_t)(j + 2) * 64 * DM); vreg2 = *(const u32x4*)(vsrc + (size_t)(j + 2) * 64 * DM); if (tid < 64) breg2 = FBbh[(j + 2) * 64 + tid]; }
            else           { kreg  = *(const u32x4*)(ksrc + (size_t)(j + 2) * 64 * DM); vreg  = *(const u32x4*)(vsrc + (size_t)(j + 2) * 64 * DM); if (tid < 64) breg  = FBbh[(j + 2) * 64 + tid]; } }
        if (wact && 64 * j <= qw0 + 31) {
            const LAS unsigned char* Kb = shm + cur * 16384; const LAS unsigned char* Vb = Kb + 8192; const LAS float* bias = (const LAS float*)(shm + L_B + cur * 256);
            f32x16 p0, p1;
#pragma unroll
            for (int g = 0; g < 4; ++g) { const f32x4 a = *(const LAS f32x4*)(bias + 8 * g + 4 * hi), c = *(const LAS f32x4*)(bias + 32 + 8 * g + 4 * hi);
                p0[4 * g] = a.x; p0[4 * g + 1] = a.y; p0[4 * g + 2] = a.z; p0[4 * g + 3] = a.w; p1[4 * g] = c.x; p1[4 * g + 1] = c.y; p1[4 * g + 2] = c.z; p1[4 * g + 3] = c.w; }
            const LAS unsigned char* kb = Kb + hi * 1024 + r32 * 16;
#pragma unroll
            for (int d0 = 0; d0 < 4; ++d0) { const bf16x8 b0 = *(const LAS bf16x8*)(kb + d0 * 2048), b1 = *(const LAS bf16x8*)(kb + d0 * 2048 + 512);
                p0 = __builtin_amdgcn_mfma_f32_32x32x16_bf16(b0, qr[d0], p0, 0, 0, 0); p1 = __builtin_amdgcn_mfma_f32_32x32x16_bf16(b1, qr[d0], p1, 0, 0, 0); }
            asm volatile("s_nop 15\n\ts_nop 7" : "+v"(p0), "+v"(p1));
            if (64 * j + 63 > qw0) {
                const int kbase = 64 * j + 4 * hi;
#pragma unroll
                for (int r = 0; r < 16; ++r) { const int kv = kbase + (r & 3) + 8 * (r >> 2); if (kv > qabs) p0[r] = NEGBIG; if (kv + 32 > qabs) p1[r] = NEGBIG; }
            }
            float ta = max3f(p0[0], p0[1], p1[0]), tb = max3f(p0[2], p0[3], p1[1]); ta = max3f(ta, p1[2], p1[3]);
#pragma unroll
            for (int r = 4; r < 16; r += 4) { ta = max3f(ta, p0[r], p0[r + 1]); tb = max3f(tb, p0[r + 2], p0[r + 3]); ta = max3f(ta, p1[r], p1[r + 1]); tb = max3f(tb, p1[r + 2], p1[r + 3]); }
            float tmax = max2f(ta, tb);
            { auto rr_ = __builtin_amdgcn_permlane32_swap(__float_as_uint(tmax), __float_as_uint(tmax), false, false);
              tmax = max2f(__uint_as_float(rr_[0]), __uint_as_float(rr_[1])); }
            const bool grow = __any(tmax > m + 8.0f);
            if (grow) {
                const float mn = max2f(m, tmax); const float alpha = __builtin_amdgcn_exp2f(m - mn); m = mn; l *= alpha;
                if (hi == 0) wsf[r32] = alpha;
            }
            p0 = p0 - m; p1 = p1 - m;
#pragma unroll
            for (int r = 0; r < 16; ++r) { p0[r] = __builtin_amdgcn_exp2f(p0[r]); p1[r] = __builtin_amdgcn_exp2f(p1[r]); }
            { const f32x16 ps = p0 + p1;
              l += ((ps[0] + ps[1]) + (ps[2] + ps[3])) + ((ps[4] + ps[5]) + (ps[6] + ps[7])) + (((ps[8] + ps[9]) + (ps[10] + ps[11])) + ((ps[12] + ps[13]) + (ps[14] + ps[15]))); }
            u32x4 pw0, pw1, pw2, pw3;
            pw0 = (u32x4){cvtpk_s(p0[0], p0[1]), cvtpk_s(p0[2], p0[3]), cvtpk_s(p0[4], p0[5]), cvtpk_s(p0[6], p0[7])};
            pw1 = (u32x4){cvtpk_s(p0[8], p0[9]), cvtpk_s(p0[10], p0[11]), cvtpk_s(p0[12], p0[13]), cvtpk_s(p0[14], p0[15])};
            pw2 = (u32x4){cvtpk_s(p1[0], p1[1]), cvtpk_s(p1[2], p1[3]), cvtpk_s(p1[4], p1[5]), cvtpk_s(p1[6], p1[7])};
            pw3 = (u32x4){cvtpk_s(p1[8], p1[9]), cvtpk_s(p1[10], p1[11]), cvtpk_s(p1[12], p1[13]), cvtpk_s(p1[14], p1[15])};
            if (grow) {
#pragma unroll
                for (int g = 0; g < 4; ++g) { const f32x4 a = *(const LAS f32x4*)(wsf + 8 * g + 4 * hi);
                    o0[4 * g] *= a.x; o0[4 * g + 1] *= a.y; o0[4 * g + 2] *= a.z; o0[4 * g + 3] *= a.w; o1[4 * g] *= a.x; o1[4 * g + 1] *= a.y; o1[4 * g + 2] *= a.z; o1[4 * g + 3] *= a.w; }
            }
            const LAS unsigned char* vp = Vb + ((lane >> 4) & 1) * 32 + (lane & 3) * 8 + (4 * hi + ((lane & 15) >> 2)) * 64;
#define ATT_PV(OD, D0, KS, PW) do { const s16x4 lo_ = vtr(vp + (D0) * 4096 + (KS) * 1024), hi_ = vtr(vp + (D0) * 4096 + (KS) * 1024 + 512); \
                const bf16x8 vf_ = (bf16x8){lo_[0], lo_[1], lo_[2], lo_[3], hi_[0], hi_[1], hi_[2], hi_[3]}; \
                OD = __builtin_amdgcn_mfma_f32_32x32x16_bf16(__builtin_bit_cast(bf16x8, PW), vf_, OD, 0, 0, 0); } while (0)
            ATT_PV(o0, 0, 0, pw0); ATT_PV(o1, 1, 0, pw0); ATT_PV(o0, 0, 1, pw1); ATT_PV(o1, 1, 1, pw1);
            ATT_PV(o0, 0, 2, pw2); ATT_PV(o1, 1, 2, pw2); ATT_PV(o0, 0, 3, pw3); ATT_PV(o1, 1, 3, pw3);
#undef ATT_PV
        }
        if (more) { const int nb = (cur ^ 1) * 16384;
            if (half == 0) { *(LAS u32x4*)(shm + nb + stoff) = kreg;  *(LAS u32x4*)(shm + nb + 8192 + stoff) = vreg;  if (tid < 64) ((LAS float*)(shm + L_B + (cur ^ 1) * 256))[tid] = breg; }
            else           { *(LAS u32x4*)(shm + nb + stoff) = kreg2; *(LAS u32x4*)(shm + nb + 8192 + stoff) = vreg2; if (tid < 64) ((LAS float*)(shm + L_B + (cur ^ 1) * 256))[tid] = breg2; } }
        __syncthreads();
      }
    }
    if (wact) {
        l += __shfl_xor(l, 32);
        if (hi == 0) wsf[r32] = 1.0f / l;
        float rli[16];
#pragma unroll
        for (int g = 0; g < 4; ++g) { const f32x4 a = *(const LAS f32x4*)(wsf + 8 * g + 4 * hi); rli[4 * g] = a.x; rli[4 * g + 1] = a.y; rli[4 * g + 2] = a.z; rli[4 * g + 3] = a.w; }
        LAS bf16_t* stg = (LAS bf16_t*)(shm + L_OST + wid * 4096);
#pragma unroll
        for (int r = 0; r < 16; ++r) { const int orow = crow(r, hi); stg[orow * 64 + r32] = (bf16_t)pk2(o0[r] * rli[r], 0.f); stg[orow * 64 + 32 + r32] = (bf16_t)pk2(o1[r] * rli[r], 0.f); }
        asm volatile("s_waitcnt lgkmcnt(0)" ::: "memory");
#pragma unroll
        for (int i = 0; i < 4; ++i) { const int row = i * 8 + (lane >> 3), ch = lane & 7; const int grow = qw0 + row;
            const u32x4 ov = *(const LAS u32x4*)(stg + row * 64 + ch * 8);
            if (grow <= lastq && dostore) { const size_t off = (rowbase + grow) * DM + h * HD + ch * 8; const size_t moff = (size_t)compact_row(b, grow) * DM + h * HD + ch * 8;
                const u32x4 mg = *(const u32x4*)(MRG + moff), sg = *(const u32x4*)(SGA + off); u32x4 w;
                w.x = pk2(bf_lo(mg.x) + bf_lo(sg.x) * bf_lo(ov.x), bf_hi(mg.x) + bf_hi(sg.x) * bf_hi(ov.x));
                w.y = pk2(bf_lo(mg.y) + bf_lo(sg.y) * bf_lo(ov.y), bf_hi(mg.y) + bf_hi(sg.y) * bf_hi(ov.y));
                w.z = pk2(bf_lo(mg.z) + bf_lo(sg.z) * bf_lo(ov.z), bf_hi(mg.z) + bf_hi(sg.z) * bf_hi(ov.z));
                w.w = pk2(bf_lo(mg.w) + bf_lo(sg.w) * bf_lo(ov.w), bf_hi(mg.w) + bf_hi(sg.w) * bf_hi(ov.w));
                *(u32x4*)(MRG + moff) = w; } }
    }
    __syncthreads();
}

__device__ __forceinline__ void attn_phase(KP p, int l, int pass, LAS unsigned char* shm) {
    unsigned* ctr = (unsigned*)(p->ws + WS_CTL) + 64 * (l + DEPTH * pass);
    const bool dostore = (pass == 0);
    const bf16_t* Qg = (const bf16_t*)(p->ws + WS_Z + 1 * SLOT); const bf16_t* Kg = (const bf16_t*)(p->ws + WS_Z + 2 * SLOT); const bf16_t* Vg = (const bf16_t*)(p->ws + WS_Z + 3 * SLOT);
    const bf16_t* SGA = (const bf16_t*)(p->ws + WS_Z + 5 * SLOT); bf16_t* MRG = (bf16_t*)p->out;
    const float* FB = (const float*)(p->ws + WS_FB);
    LAS unsigned* qw = (LAS unsigned*)(shm + L_Q);
    constexpr int NUNITS = 64 * 33;
    unsigned nxt = 0u;
    if (threadIdx.x == 0) nxt = __hip_atomic_fetch_add(ctr, 1u, __ATOMIC_RELAXED, __HIP_MEMORY_SCOPE_AGENT);
    for (;;) {
        if (threadIdx.x == 0) *qw = nxt;
        __syncthreads();
        const int idx = (int)*qw;
        __syncthreads();
        if (threadIdx.x == 0) nxt = __hip_atomic_fetch_add(ctr, 1u, __ATOMIC_RELAXED, __HIP_MEMORY_SCOPE_AGENT);
        if (idx >= NUNITS) {
            const int ci = idx - NUNITS;
            if (pass != 0 || ci >= conv_count(l + 1, true) * PROBE_CONV_REPS) break;
            conv_wg_item(p, l + 1, l, ci % conv_count(l + 1, true), shm);
            continue; }
        const int qb = 32 - idx / 64, bh = idx % 64;
        const int q0 = qb == 0 ? 0 : META + 256 * (qb - 1), nrows = qb == 0 ? META : 256;
        const unsigned* nt = (const unsigned*)(p->ws + WS_CTL) + CW_NORM + ((l * NB + (bh >> 4)) * 2) * NH + (bh & 15);
        const float qn2 = __builtin_bit_cast(float, nt[0]), kn2 = __builtin_bit_cast(float, nt[NH]);
        const float skipB = 38.0f + 2.0f * sqrtf(qn2) * sqrtf(kn2) * 1.001f;
        attn_unit(bh >> 4, bh & 15, q0, nrows, Qg, Kg, Vg, SGA, MRG, FB + (size_t)bh * TT, skipB, dostore, shm);
    }
}
}


#define XB_TMO      128
#define XB_XCNT(j)  (256  + 64 * (j))
#define XB_XSUB(j)  (1280 + 64 * (j))
#define XB_XGEN(j)  (2304 + 64 * (j))
#define XB_TOP      3328
#define XB_TOPGEN   3392
#define XCD_BAR_WORDS 3456
#define XB_SPIN_CAP (1u << 22)
constexpr int CW_BAR = 1024;
constexpr size_t CTL_ZERO_BYTES = (size_t)(CW_BAR + XCD_BAR_WORDS) * 4;
constexpr int LDS_XB = 139264 + 256;
__device__ __forceinline__ unsigned xb_ld(unsigned* p)              { return __hip_atomic_load(p, __ATOMIC_RELAXED, __HIP_MEMORY_SCOPE_AGENT); }
__device__ __forceinline__ unsigned xb_add(unsigned* p, unsigned v) { return __hip_atomic_fetch_add(p, v, __ATOMIC_RELAXED, __HIP_MEMORY_SCOPE_AGENT); }
__device__ __forceinline__ unsigned xb_xcc_id() { return (unsigned)__builtin_amdgcn_s_getreg((3 << 11) | 20) & 0xFu; }
#define XB_SPIN(cond, bar) do { unsigned _sp = 0; while (cond) { __builtin_amdgcn_s_sleep(1); \
    if ((++_sp & 255u) == 0u) { if (xb_ld(&(bar)[XB_TMO])) break; if (_sp > XB_SPIN_CAP) { atomicAdd(&(bar)[XB_TMO], 1u); break; } } } } while (0)
struct XcdBarrier { unsigned* bar; unsigned x; volatile LAS unsigned* st; };
__device__ __forceinline__ XcdBarrier xcd_barrier_post(unsigned* bar, volatile LAS unsigned* st) {
    XcdBarrier b; b.bar = bar; b.x = xb_xcc_id(); b.st = st;
    if (threadIdx.x == 0) (void)xb_add(&bar[XB_XCNT(b.x)], 1u);
    return b;
}
__device__ __forceinline__ void xcd_barrier_complete(unsigned* bar, unsigned x, unsigned& nloc, unsigned& nx) {
    const unsigned G = gridDim.x * gridDim.y * gridDim.z;
    unsigned sum, cnt, mine, sp = 0u;
    for (;;) {
        sum = 0u; cnt = 0u; mine = 0u;
#pragma unroll
        for (unsigned j = 0; j < 16; ++j) { const unsigned c = xb_ld(&bar[XB_XCNT(j)]); sum += c; cnt += (c > 0u) ? 1u : 0u; mine = (j == x) ? c : mine; }
        if (sum == G) break;
        __builtin_amdgcn_s_sleep(1);
        if ((++sp & 255u) == 0u) { if (xb_ld(&bar[XB_TMO])) break; if (sp > XB_SPIN_CAP) { atomicAdd(&bar[XB_TMO], 1u); break; } }
    }
    nloc = mine > 0u ? mine : 1u; nx = cnt > 0u ? cnt : 1u;
}
__device__ __forceinline__ void xcd_barrier(unsigned* bar, volatile LAS unsigned* st) {
    asm volatile("s_waitcnt vmcnt(0)" ::: "memory");
    __syncthreads();
    if (threadIdx.x == 0) {
        const unsigned x = xb_xcc_id();
        __builtin_amdgcn_s_waitcnt(0);
        unsigned nloc = st[0], nx = st[1];
        if (nloc == 0u) { xcd_barrier_complete(bar, x, nloc, nx); st[0] = nloc; st[1] = nx; }
        const unsigned old = xb_add(&bar[XB_XSUB(x)], 1u);
        const unsigned gen = old / nloc;
        if (old + 1u == (gen + 1u) * nloc) {
            __builtin_amdgcn_fence(__ATOMIC_RELEASE, "agent");
            asm volatile("s_waitcnt vmcnt(0)" ::: "memory");
            const unsigned og = xb_add(&bar[XB_TOP], 1u);
            const unsigned tg = og / nx;
            if (og + 1u == (tg + 1u) * nx) xb_add(&bar[XB_TOPGEN], 1u);
            else XB_SPIN(xb_ld(&bar[XB_TOPGEN]) == tg, bar);
            __builtin_amdgcn_fence(__ATOMIC_ACQUIRE, "agent");
            xb_add(&bar[XB_XGEN(x)], 1u);
            asm volatile("s_waitcnt vmcnt(0)" ::: "memory");
        } else {
            XB_SPIN(xb_ld(&bar[XB_XGEN(x)]) == gen, bar);
            __builtin_amdgcn_fence(__ATOMIC_ACQUIRE, "agent");
            asm volatile("s_waitcnt vmcnt(0)" ::: "memory");
        }
    }
    __syncthreads();
}

__global__ void __launch_bounds__(512, 2) mega_fwd(Params p_unused) {
    extern __shared__ __attribute__((aligned(16))) unsigned char lds_raw[];
    LAS unsigned char* lds = (LAS unsigned char*)lds_raw;
    cg::grid_group grid = cg::this_grid();
    { unsigned* ctl0 = (unsigned*)(params_opaque()->ws + WS_CTL);
      if (threadIdx.x == 0) { ((volatile LAS unsigned*)(lds + LDS_XB))[0] = 0u; ((volatile LAS unsigned*)(lds + LDS_XB))[1] = 0u; }
      if (blockIdx.x == 0) { unsigned zz = 0u; asm volatile("" : "+v"(zz));
          for (int i = (int)threadIdx.x; i < (int)(CTL_ZERO_BYTES / 4); i += 512) ctl0[i] = zz; } }
    __syncthreads();

    { KP p = params_opaque();
      for (int ci = blockIdx.x; ci < CV_Z + CV_IN8; ci += gridDim.x) conv_wg_item(p, 0, 0, ci, lds);
      norm_pass<0>(p, nullptr);
    }
    grid.sync();
    { unsigned* barw = (unsigned*)(params_opaque()->ws + WS_CTL) + CW_BAR; const unsigned xcc = xb_xcc_id();
      if (threadIdx.x == 0) (void)xb_add(barw + XB_XCNT(xcc), 1u); }

#pragma unroll 1
    for (int l = 0; l < DEPTH; ++l) {
        { KP p = params_opaque(); unsigned char* ws = p->ws;
          pg8::Gemm g{(const bf16_t*)(ws + WS_HB), (const bf16_t*)(ws + WS_WIN), MM, NIN, DM}; pg8::StaticOrder S; S.init(MM, NIN, (int)gridDim.x, (int)blockIdx.x);
          { const int t = tid_opaque(); if (t < NH) ((LAS float*)(lds + LDS_BF))[t] = p->b_forget[l * NH + t]; }
          __syncthreads();
          { sk::EpiInM EM{(bf16_t*)(ws + WS_Z), (LAS const float*)(lds + LDS_BF), (const float*)(ws + WS_RSTD)}; sk::phase<DM>(lds, (const bf16_t*)(ws + WS_HB) + (size_t)MM * DM, (const bf16_t*)(ws + WS_WIN), EM, (int)gridDim.x / 2, (int)gridDim.x - (int)gridDim.x / 2); }
          pg8::EpiIn E{(bf16_t*)(ws + WS_Z), (LAS const float*)(lds + LDS_BF), (const float*)(ws + WS_RSTD)};
          _Pragma("unroll 1") for (int rep = 0; rep < PROBE_GEMM_REPS * PROBE_A_REPS; ++rep) pg8::gemm_phase<pg8::EpiIn, pg8::StaticOrder, true>(lds, g, S, E); }
        GSYNC();
        { KP p = params_opaque();
          _Pragma("unroll 1") for (int rep = 0; rep < PROBE_S_REPS; ++rep) {
          { const int sb = (gridDim.x == 256u) ? 192 : 0;
            if ((int)blockIdx.x >= sb && (int)blockIdx.x < sb + 64) scan_unit(p, (int)blockIdx.x - sb, lds); }
          qknorm_phase(p, l, lds);
          poolgate_phase(p, l); } }
        GSYNC();
        { KP p = params_opaque(); _Pragma("unroll 1") for (int pass = 0; pass < PROBE_ATT_REPS; ++pass) att::attn_phase(p, l, pass, lds); }
        GSYNC();
        { KP p = params_opaque(); unsigned char* ws = p->ws;
          { sk::EpiPlainM EM{(bf16_t*)(ws + WS_MIX)}; sk::phase<DM>(lds, (const bf16_t*)p->out + (size_t)MM * DM, (const bf16_t*)(ws + WS_WOUT), EM, 0, (int)gridDim.x); }
          pg8::Gemm g{(const bf16_t*)p->out, (const bf16_t*)(ws + WS_WOUT), MM, DM, DM}; pg8::StaticOrder S; S.init(MM, DM, (int)gridDim.x, (int)blockIdx.x);
          pg8::EpiPlain E{(bf16_t*)(ws + WS_MIX), DM};
          _Pragma("unroll 1") for (int rep = 0; rep < PROBE_GEMM_REPS * PROBE_C_REPS; ++rep) pg8::gemm_phase<pg8::EpiPlain, pg8::StaticOrder, true>(lds, g, S, E); }
        GSYNC();
        { KP p = params_opaque(); _Pragma("unroll 1") for (int rep = 0; rep < PROBE_NORM_DRY; ++rep) norm_pass<1, true>(p, p->n_mix_post + l * DM);
          norm_pass<1>(p, p->n_mix_post + l * DM); }
        GSYNC();
        { KP p = params_opaque(); unsigned char* ws = p->ws;
          { sk::EpiSwigluM EM{(bf16_t*)(ws + WS_FF), (const float*)(ws + WS_RSTD)}; sk::phase<DM>(lds, (const bf16_t*)(ws + WS_HB) + (size_t)MM * DM, (const bf16_t*)(ws + WS_WGU), EM, 0, (int)gridDim.x); }
          pg8::Gemm g{(const bf16_t*)(ws + WS_HB), (const bf16_t*)(ws + WS_WGU), MM, NGU, DM}; pg8::StaticOrder S; S.init(MM, NGU, (int)gridDim.x, (int)blockIdx.x);
          pg8::EpiSwiglu E{(bf16_t*)(ws + WS_FF), (const float*)(ws + WS_RSTD)};
          _Pragma("unroll 1") for (int rep = 0; rep < PROBE_GEMM_REPS * PROBE_D_REPS; ++rep) pg8::gemm_phase<pg8::EpiSwiglu, pg8::StaticOrder, true>(lds, g, S, E); }
        GSYNC();
        { KP p = params_opaque(); unsigned char* ws = p->ws;
          { sk::EpiPlainM EM{(bf16_t*)(ws + WS_MIX)}; sk::phase<DFF>(lds, (const bf16_t*)(ws + WS_FF) + (size_t)MM * DFF, (const bf16_t*)(ws + WS_WDN), EM, 0, (int)gridDim.x); }
          pg8::Gemm g{(const bf16_t*)(ws + WS_FF), (const bf16_t*)(ws + WS_WDN), MM, DM, DFF}; pg8::StaticOrder S; S.init(MM, DM, (int)gridDim.x, (int)blockIdx.x);
          pg8::EpiPlain E{(bf16_t*)(ws + WS_MIX), DM};
          _Pragma("unroll 1") for (int rep = 0; rep < PROBE_GEMM_REPS * PROBE_E_REPS; ++rep) pg8::gemm_phase<pg8::EpiPlain, pg8::StaticOrder, true>(lds, g, S, E); }
        GSYNC();
        { KP p = params_opaque();
          if (l + 1 < DEPTH) norm_pass<1>(p, p->n_ffn_post + l * DM); else norm_pass<2>(p, p->n_ffn_post + l * DM); }
        if (l + 1 < DEPTH) GSYNC();
    }
}

extern "C" void kernel_launch(void* const* d_in, const int* in_sizes, int n_in, void* d_out, int out_size, void* d_ws, size_t ws_size, hipStream_t stream) {
    static int grid_blocks = 0;
    if (grid_blocks == 0) {
        if (n_in != 14 || ws_size < WS_END) { fprintf(stderr, "kernel_launch: unexpected n_in %d or ws_size %zu (< %zu)\n", n_in, ws_size, (size_t)WS_END); grid_blocks = -1; return; }
        int dev = 0, cus = 0, per_cu = 0;
        hipGetDevice(&dev);
        hipDeviceGetAttribute(&cus, hipDeviceAttributeMultiprocessorCount, dev);
        if (hipFuncSetAttribute((const void*)mega_fwd, hipFuncAttributeMaxDynamicSharedMemorySize, LDS_BYTES) != hipSuccess) { fprintf(stderr, "kernel_launch: hipFuncSetAttribute failed\n"); grid_blocks = -1; return; }
        hipOccupancyMaxActiveBlocksPerMultiprocessor(&per_cu, (const void*)mega_fwd, 512, LDS_BYTES);
        if (per_cu < 1) per_cu = 1;
        grid_blocks = cus * per_cu;
        (void)hipGetLastError();
    }
    if (grid_blocks < 0) return;
    Params p{};
    p.x = (const float*)d_in[0]; p.meta = (const float*)d_in[1]; p.n_mix_pre = (const float*)d_in[2]; p.n_mix_post = (const float*)d_in[3];
    p.n_ffn_pre = (const float*)d_in[4]; p.n_ffn_post = (const float*)d_in[5]; p.w_in = (const float*)d_in[6]; p.b_forget = (const float*)d_in[7];
    p.w_pool = (const float*)d_in[8]; p.pool_scale = (const float*)d_in[9]; p.w_out = (const float*)d_in[10]; p.w_gate = (const float*)d_in[11];
    p.w_up = (const float*)d_in[12]; p.w_down = (const float*)d_in[13];
    p.out = (float*)d_out; p.ws = (unsigned char*)d_ws;
    void* args[] = {&p};
    hipError_t e = hipLaunchCooperativeKernel((const void*)mega_fwd, dim3(grid_blocks), dim3(512), args, LDS_BYTES, stream);
    if (e != hipSuccess) fprintf(stderr, "cooperative launch failed: %s (grid %d)\n", hipGetErrorString(e), grid_blocks);
}
```

```cpp
#include <hip/hip_runtime.h>
#include <hip/hip_cooperative_groups.h>
#include <cstdio>
#include <cstdint>
namespace cg = cooperative_groups;

#define LAS __attribute__((address_space(3)))
__device__ __forceinline__ int tid_opaque() { int t = threadIdx.x; asm volatile("" : "+v"(t)); return t; }
typedef unsigned short bf16_t;
typedef short bf16x8 __attribute__((ext_vector_type(8)));
typedef short s16x4 __attribute__((ext_vector_type(4)));
typedef float f32x4 __attribute__((ext_vector_type(4)));
typedef float f32x2 __attribute__((ext_vector_type(2)));
typedef float f32x16 __attribute__((ext_vector_type(16)));
typedef unsigned u32x4 __attribute__((ext_vector_type(4)));
typedef unsigned u32x2 __attribute__((ext_vector_type(2)));
typedef __bf16 bf16x2_t __attribute__((ext_vector_type(2)));

constexpr int NB = 4, SEQ = 8192, META = 16, TT = SEQ + META, DM = 1024, NH = 16, HD = 64, DFF = 2816, DEPTH = 4;
constexpr int MREAL = NB * TT;
constexpr int MP = 33024;
constexpr int MM = NB * SEQ;
constexpr int NIN_SRC = 6160;
constexpr int NIN = 6144;
constexpr int NGU = 2 * DFF;
constexpr float RMS_EPS = 1e-6f;
constexpr float LOG2E = 1.4426950408889634f;
constexpr float C2 = 0.125f * LOG2E;
constexpr float NEGBIG = -1e30f;
__device__ __forceinline__ int compact_row(int b, int t) { return t < META ? MM + b * META + t : b * SEQ + (t - META); }

constexpr size_t MiB = 1u << 20;
constexpr size_t WS_CTL = 0;
constexpr size_t WS_LOGF = 1 * MiB;
constexpr size_t WS_FB = 4 * MiB;
constexpr size_t WS_RSTD = 7 * MiB;
constexpr size_t WS_WIN = 8 * MiB;
constexpr size_t WS_WOUT = 21 * MiB;
constexpr size_t WS_WGU = 23 * MiB;
constexpr size_t WS_WDN = 34 * MiB;
constexpr size_t SLOT = 65 * MiB;
constexpr size_t WS_HB = 40 * MiB;
constexpr size_t WS_Z = WS_HB + SLOT;
constexpr size_t WS_V = WS_Z + 3 * SLOT;
constexpr size_t WS_MIX = WS_V;
constexpr size_t WS_FF = WS_Z;
constexpr size_t WS_END = WS_Z + 6 * SLOT;
static_assert((size_t)MP * DM * 2 <= SLOT, "slot");
static_assert((size_t)MP * DFF * 2 <= 3 * SLOT, "ff overlay");
static_assert((size_t)(NIN + 32) * DM * 2 <= 13 * MiB && (size_t)NGU * DM * 2 <= 11 * MiB && (size_t)DM * DFF * 2 <= 6 * MiB, "weights");

#ifndef PROBE_A_REPS
#define PROBE_A_REPS 1
#endif
#ifndef PROBE_C_REPS
#define PROBE_C_REPS 1
#endif
#ifndef PROBE_D_REPS
#define PROBE_D_REPS 1
#endif
#ifndef PROBE_E_REPS
#define PROBE_E_REPS 1
#endif
#ifndef PROBE_GEMM_REPS
#define PROBE_GEMM_REPS 1
#endif
#ifndef PROBE_ATT_REPS
#define PROBE_ATT_REPS 1
#endif
#ifndef PROBE_S_REPS
#define PROBE_S_REPS 1
#endif
#ifndef PROBE_CONV_REPS
#define PROBE_CONV_REPS 1
#endif
#ifndef PROBE_NORM_DRY
#define PROBE_NORM_DRY 0
#endif
#ifndef PROBE_SYNC_REPS
#define PROBE_SYNC_REPS 1
#endif
#define GSYNC() do { _Pragma("unroll 1") for (int rep_ = 0; rep_ < PROBE_SYNC_REPS; ++rep_) xcd_barrier((unsigned*)(params_opaque()->ws + WS_CTL) + CW_BAR, (volatile LAS unsigned*)(lds + LDS_XB)); } while (0)
constexpr int LDS_BYTES = 147456;
constexpr int LDS_BF = 139264;

namespace pg8 {
constexpr int BM = 256, BK = 64, HALF = 128, HTB = HALF * BK * 2, STAGE_BYTES = 8 * HTB, NXCD = 8, WGM = 4;
__host__ __device__ __forceinline__ int lds_byte(int r, int c) { const int st = (r >> 4) * 2 + (c >> 5), rr = r & 15, cc = c & 31, ob = rr * 64 + cc * 2; return st * 1024 + (ob ^ (((ob >> 9) & 1) << 5)); }
__host__ __device__ __forceinline__ void stage_rc(int b, int& R, int& C) { const int st = b / 1024, sb = b % 1024, swz = sb ^ (((sb >> 9) & 1) << 5); R = (st >> 1) * 16 + swz / 64; C = (st & 1) * 32 + (swz % 64) / 2; }
__host__ __device__ __forceinline__ int perm32(int rho) { const int n = rho >> 4, i = rho & 15; return 8 * (i >> 2) + 4 * n + (i & 3); }
struct Unit { int pm, pn; };
struct Gemm { const bf16_t* A; const bf16_t* Bt; int M, N, K; };
struct StaticOrder {
    int nM, nN, nwg, G, c;
    __device__ void init(int M, int N, int G_, int c_) { nM = M / BM; nN = N / BM; nwg = nM * nN; G = G_; c = c_; }
    __device__ bool next(int i, Unit& u) const {
        const long L = (long)i * G + c; if (L >= nwg) return false;
        int wgid = (int)L; { const int q = nwg / NXCD, r = nwg % NXCD, xcd = wgid % NXCD, off = wgid / NXCD; wgid = (xcd < r ? xcd * (q + 1) : r * (q + 1) + (xcd - r) * q) + off; }
        const int nig = WGM * nN, gid = wgid / nig, fm = gid * WGM, gsz = (nM - fm) < WGM ? (nM - fm) : WGM;
        u.pm = fm + ((wgid % nig) % gsz); u.pn = (wgid % nig) / gsz; return true;
    }
    __device__ __forceinline__ void a_ready(const Unit&) const {}
    __device__ __forceinline__ void done(const Unit&) const {}
};
__device__ __forceinline__ unsigned cvt_pk_bf16(float lo, float hi) { typedef float f2_ __attribute__((ext_vector_type(2))); typedef __bf16 b2_ __attribute__((ext_vector_type(2))); f2_ v = {lo, hi}; b2_ b = __builtin_convertvector(v, b2_); return __builtin_bit_cast(unsigned, b); }
__device__ __forceinline__ float sigmoidf_(float x) { return __builtin_amdgcn_rcpf(1.0f + __builtin_amdgcn_exp2f(-x * LOG2E)); }

struct EpiPlain {
    static constexpr bool PERM = true, AFTER_DRAIN = false;
    bf16_t* O; int ldc;
    __device__ __forceinline__ void operator()(const f32x4 (&acc)[2][2][4][2], const Unit& u, int wr, int wc, int fr, int fq) const {
        const int row0 = u.pm * BM + wr * 64 + fr; const int col0 = u.pn * BM + wc * 32 + 8 * fq;
#pragma unroll
        for (int ai = 0; ai < 2; ++ai)
#pragma unroll
            for (int m = 0; m < 4; ++m) { bf16_t* rowp = O + (size_t)(row0 + ai * HALF + m * 16) * ldc + col0;
#pragma unroll
                for (int bj = 0; bj < 2; ++bj) { const f32x4 v0 = acc[ai][bj][m][0], v1 = acc[ai][bj][m][1];
                    u32x4 w; w.x = cvt_pk_bf16(v0[0], v0[1]); w.y = cvt_pk_bf16(v0[2], v0[3]); w.z = cvt_pk_bf16(v1[0], v1[1]); w.w = cvt_pk_bf16(v1[2], v1[3]);
                    *(u32x4*)(rowp + bj * HALF) = w; } }
    }
};
struct EpiIn {
    static constexpr bool PERM = true, AFTER_DRAIN = false;
    bf16_t* Z; const float* rstd;
    __device__ __forceinline__ void operator()(const f32x4 (&acc)[2][2][4][2], const Unit& u, int wr, int wc, int fr, int fq) const {
        const int row0 = u.pm * BM + wr * 64 + fr + META * ((u.pm >> 5) + 1);
        {
            const int kind = u.pn >> 2; bf16_t* base = Z + (size_t)kind * (SLOT / 2); const int col0 = (u.pn & 3) * BM + wc * 32 + 8 * fq;
#pragma unroll
            for (int ai = 0; ai < 2; ++ai)
#pragma unroll
                for (int m = 0; m < 4; ++m) { bf16_t* rowp = base + (size_t)(row0 + ai * HALF + m * 16) * DM + col0;
                    const float rs = rstd[u.pm * BM + wr * 64 + fr + ai * HALF + m * 16];
#pragma unroll
                    for (int bj = 0; bj < 2; ++bj) { f32x4 v0 = acc[ai][bj][m][0] * rs, v1 = acc[ai][bj][m][1] * rs;
                        if (kind == 1) { v0 = v0 * C2; v1 = v1 * C2; }
                        else if (kind >= 4) {
#pragma unroll
                            for (int i = 0; i < 4; ++i) { v0[i] = sigmoidf_(v0[i]); v1[i] = sigmoidf_(v1[i]); } }
                        u32x4 w; w.x = cvt_pk_bf16(v0[0], v0[1]); w.y = cvt_pk_bf16(v0[2], v0[3]); w.z = cvt_pk_bf16(v1[0], v1[1]); w.w = cvt_pk_bf16(v1[2], v1[3]);
                        *(u32x4*)(rowp + bj * HALF) = w; } }
        }
    }
};
struct EpiSwiglu {
    static constexpr bool PERM = true, AFTER_DRAIN = false;
    bf16_t* O; const float* rstd;
    __device__ __forceinline__ void operator()(const f32x4 (&acc)[2][2][4][2], const Unit& u, int wr, int wc, int fr, int fq) const {
        const int row0 = u.pm * BM + wr * 64 + fr; const int col0 = u.pn * HALF + wc * 32 + 8 * fq;
#pragma unroll
        for (int ai = 0; ai < 2; ++ai)
#pragma unroll
            for (int m = 0; m < 4; ++m) { bf16_t* rowp = O + (size_t)(row0 + ai * HALF + m * 16) * DFF + col0;
                f32x4 r0, r1; const float rs = rstd[row0 + ai * HALF + m * 16];
#pragma unroll
                for (int i = 0; i < 4; ++i) { const float g0 = acc[ai][0][m][0][i] * rs, g1 = acc[ai][0][m][1][i] * rs;
                    r0[i] = g0 * sigmoidf_(g0) * (acc[ai][1][m][0][i] * rs); r1[i] = g1 * sigmoidf_(g1) * (acc[ai][1][m][1][i] * rs); }
                u32x4 w; w.x = cvt_pk_bf16(r0[0], r0[1]); w.y = cvt_pk_bf16(r0[2], r0[3]); w.z = cvt_pk_bf16(r1[0], r1[1]); w.w = cvt_pk_bf16(r1[2], r1[3]);
                *(u32x4*)rowp = w; }
    }
};

template <class Epi, class Sched, bool ALIGN_EPI = false>
__device__ __forceinline__ void gemm_phase(LAS unsigned char* lds, const Gemm g, const Sched& S, const Epi& E) {
    const int tid = tid_opaque(), wid = __builtin_amdgcn_readfirstlane(tid >> 6), lane = tid & 63, wr = wid >> 2, wc = wid & 3, fr = lane & 15, fq = lane >> 4;
    const int K = g.K, nt = K / BK;
    unsigned voffA[2], voffB[2];
#pragma unroll
    for (int i = 0; i < 2; ++i) { int R, C; stage_rc(tid * 16 + i * 8192, R, C); const int Rb = Epi::PERM ? ((R & ~31) + perm32(R & 31)) : R;
        voffA[i] = (unsigned)(R * K + C) * 2u; voffB[i] = (unsigned)(Rb * K + C) * 2u; }
    const size_t kstep = (size_t)(BK * 2);
    const size_t hstep = (size_t)HALF * K * 2;
    const size_t tstep = 2 * hstep;
    const unsigned ldsw = (unsigned)wid * 1024u;
    const int aoff = lds_byte(wr * 64 + fr, fq * 8), boff = lds_byte(wc * 32 + fr, fq * 8);
#define PG8_SA(b, h) (((b) * 2 + (h)) * HTB)
#define PG8_SB(b, h) ((4 + (b) * 2 + (h)) * HTB)
#define PG8_STAGE(bufoff, gbase, voff) do { _Pragma("unroll") for (int _i = 0; _i < 2; ++_i) \
        __builtin_amdgcn_global_load_lds((const unsigned*)((const char*)(gbase) + (voff)[_i]), (LAS unsigned*)(lds + (bufoff) + ldsw + _i * 8192), 16, 0, 0); } while (0)
#define PG8_LDA(dst, b, h) do { _Pragma("unroll") for (int m = 0; m < 4; ++m) _Pragma("unroll") for (int k = 0; k < 2; ++k) dst[m][k] = *(const LAS bf16x8*)(lds + PG8_SA(b, h) + aoff + m * 2048 + k * 1024); } while (0)
#define PG8_LDB(dst, b, h) do { _Pragma("unroll") for (int n = 0; n < 2; ++n) _Pragma("unroll") for (int k = 0; k < 2; ++k) dst[n][k] = *(const LAS bf16x8*)(lds + PG8_SB(b, h) + boff + n * 2048 + k * 1024); } while (0)
#define PG8_MMA(ai, bj, At, Bt) do { __builtin_amdgcn_s_setprio(1); _Pragma("unroll") for (int m = 0; m < 4; ++m) _Pragma("unroll") for (int n = 0; n < 2; ++n) _Pragma("unroll") for (int k = 0; k < 2; ++k) \
        acc[ai][bj][m][n] = __builtin_amdgcn_mfma_f32_16x16x32_bf16(Bt[n][k], At[m][k], acc[ai][bj][m][n], 0, 0, 0); __builtin_amdgcn_s_setprio(0); } while (0)
#define PG8_WAIT_V(n) asm volatile("s_waitcnt vmcnt(" #n ")" ::: "memory")
#define PG8_WAIT_L(n) asm volatile("s_waitcnt lgkmcnt(" #n ")" ::: "memory")
#define PG8_BAR __builtin_amdgcn_s_barrier()
#define PG8_SCHED __builtin_amdgcn_sched_barrier(0)
    Unit cur, nxt; int ui = 0;
    if (!S.next(0, cur)) return;
    f32x4 acc[2][2][4][2];
    float zf = 0.f; asm volatile("" : "+v"(zf));
#pragma unroll
    for (int a = 0; a < 2; ++a)
#pragma unroll
        for (int b = 0; b < 2; ++b)
#pragma unroll
            for (int m = 0; m < 4; ++m)
#pragma unroll
                for (int n = 0; n < 2; ++n) acc[a][b][m][n] = (f32x4){zf, zf, zf, zf};
    bf16x8 At[4][2], B0[2][2], B1[2][2];
    const char* cA = (const char*)g.A + (size_t)cur.pm * tstep; const char* cB = (const char*)g.Bt + (size_t)cur.pn * tstep;
    S.a_ready(cur);
    PG8_STAGE(PG8_SB(0, 0), cB, voffB); PG8_STAGE(PG8_SB(0, 1), cB + hstep, voffB); PG8_STAGE(PG8_SA(0, 0), cA, voffA); PG8_STAGE(PG8_SA(0, 1), cA + hstep, voffA);
    if (wr == 1) PG8_BAR;
    PG8_WAIT_V(2); PG8_BAR;
    PG8_STAGE(PG8_SB(1, 0), cB + kstep, voffB); PG8_STAGE(PG8_SA(1, 0), cA + kstep, voffA); PG8_STAGE(PG8_SB(1, 1), cB + hstep + kstep, voffB);
    PG8_WAIT_V(6); PG8_BAR;
    for (;;) {
        const bool has_next = S.next(ui + 1, nxt);
        const char* nA = has_next ? (const char*)g.A + (size_t)nxt.pm * tstep : cA; const char* nB = has_next ? (const char*)g.Bt + (size_t)nxt.pn * tstep : cB;
        for (int t = 0; t < nt; t += 2) {
            const bool last = (t == nt - 2);
            const char* a1 = cA + (size_t)(t + 1) * kstep;
            const char* a2 = last ? nA : cA + (size_t)(t + 2) * kstep; const char* b2 = last ? nB : cB + (size_t)(t + 2) * kstep;
            const char* a3 = a2 + kstep; const char* b3 = b2 + kstep;
            if (last && has_next) S.a_ready(nxt);
            PG8_LDB(B0, 0, 0); PG8_LDB(B1, 0, 1); PG8_SCHED; PG8_LDA(At, 0, 0); PG8_STAGE(PG8_SA(1, 1), a1 + hstep, voffA);
            PG8_WAIT_V(8); PG8_WAIT_L(0); PG8_BAR; PG8_MMA(0, 0, At, B0); PG8_MMA(0, 1, At, B1); PG8_BAR; PG8_SCHED;
            PG8_LDA(At, 0, 1); PG8_STAGE(PG8_SB(0, 0), b2, voffB); PG8_STAGE(PG8_SB(0, 1), b2 + hstep, voffB); PG8_STAGE(PG8_SA(0, 0), a2, voffA);
            PG8_WAIT_V(8); PG8_WAIT_L(0); PG8_BAR; PG8_MMA(1, 0, At, B0); PG8_MMA(1, 1, At, B1); PG8_BAR; PG8_SCHED;
            PG8_LDB(B0, 1, 0); PG8_LDB(B1, 1, 1); PG8_SCHED; PG8_LDA(At, 1, 0); PG8_STAGE(PG8_SA(0, 1), a2 + hstep, voffA);
            PG8_WAIT_V(8); PG8_WAIT_L(0); PG8_BAR; PG8_MMA(0, 0, At, B0); PG8_MMA(0, 1, At, B1); PG8_BAR; PG8_SCHED;
            PG8_LDA(At, 1, 1); PG8_STAGE(PG8_SB(1, 0), b3, voffB); PG8_STAGE(PG8_SB(1, 1), b3 + hstep, voffB); PG8_STAGE(PG8_SA(1, 0), a3, voffA);
            PG8_WAIT_V(8); PG8_WAIT_L(0); PG8_BAR; PG8_MMA(1, 0, At, B0); PG8_MMA(1, 1, At, B1); PG8_BAR; PG8_SCHED;
        }
        if constexpr (ALIGN_EPI) { if (wr == 0) PG8_BAR; }
        E(acc, cur, wr, wc, fr, fq); S.done(cur);
        if (!has_next) break;
#pragma unroll
        for (int a = 0; a < 2; ++a)
#pragma unroll
            for (int b = 0; b < 2; ++b)
#pragma unroll
                for (int m = 0; m < 4; ++m)
#pragma unroll
                    for (int n = 0; n < 2; ++n) acc[a][b][m][n] = (f32x4){zf, zf, zf, zf};
        cur = nxt; cA = nA; cB = nB; ++ui;
        if constexpr (ALIGN_EPI) { if (wr == 1) PG8_BAR; }
    }
    PG8_WAIT_V(0);
    if constexpr (!ALIGN_EPI) { if (wr == 0) PG8_BAR; }
    PG8_BAR;
#undef PG8_SA
#undef PG8_SB
#undef PG8_STAGE
#undef PG8_LDA
#undef PG8_LDB
#undef PG8_MMA
#undef PG8_WAIT_V
#undef PG8_WAIT_L
#undef PG8_BAR
#undef PG8_SCHED
}
}

__device__ __forceinline__ unsigned f2bf(float f) { unsigned u = __builtin_bit_cast(unsigned, f); return (u + 0x7fffu + ((u >> 16) & 1u)) >> 16; }
__device__ __forceinline__ unsigned pk2(float lo, float hi) { f32x2 v = {lo, hi}; bf16x2_t b = __builtin_convertvector(v, bf16x2_t); return __builtin_bit_cast(unsigned, b); }
__device__ __forceinline__ float bf_lo(unsigned w) { return __builtin_bit_cast(float, w << 16); }
__device__ __forceinline__ float bf_hi(unsigned w) { return __builtin_bit_cast(float, w & 0xffff0000u); }
__device__ __forceinline__ float wave_sum(float v) {
#pragma unroll
    for (int o = 1; o < 64; o <<= 1) v += __shfl_xor(v, o);
    return v;
}
__device__ __forceinline__ unsigned cvtpk_s(float lo, float hi) { f32x2 v = {lo, hi}; bf16x2_t b = __builtin_convertvector(v, bf16x2_t); return __builtin_bit_cast(unsigned, b); }

struct Params {
    const float* x; const float* meta; const float* n_mix_pre; const float* n_mix_post; const float* n_ffn_pre; const float* n_ffn_post;
    const float* w_in; const float* b_forget; const float* w_pool; const float* pool_scale; const float* w_out; const float* w_gate; const float* w_up; const float* w_down;
    float* out; unsigned char* ws;
};
typedef const __attribute__((address_space(4))) Params* KP;
__device__ __forceinline__ KP params_opaque() { KP q = (KP)__builtin_amdgcn_kernarg_segment_ptr(); asm volatile("" : "+s"(q)); return q; }


namespace sk {
struct EpiInM {
    bf16_t* Z; const float* rstd;
    static constexpr int NBB = 1;
    __device__ __forceinline__ int nunits() const { return NIN / 16; }
    __device__ __forceinline__ int brow(int u, int nb) const { return 16 * u; }
    __device__ __forceinline__ void operator()(const f32x4 (&a)[1], int u, int rb, int fr, int fq) const {
        const int n0 = 16 * u; const size_t nrow = (size_t)rb * TT + fr;
        const float rs = rstd[MM + 16 * rb + fr];
        const int kind = n0 >> 10; f32x4 v = a[0] * rs;
        if (kind == 1) v = v * C2; else if (kind >= 4) { v[0] = pg8::sigmoidf_(v[0]); v[1] = pg8::sigmoidf_(v[1]); v[2] = pg8::sigmoidf_(v[2]); v[3] = pg8::sigmoidf_(v[3]); }
        *(u32x2*)(Z + (size_t)kind * (SLOT / 2) + nrow * DM + (n0 & 1023) + 4 * fq) = (u32x2){pg8::cvt_pk_bf16(v[0], v[1]), pg8::cvt_pk_bf16(v[2], v[3])};
    }
};
__device__ __forceinline__ void forget_phase(const bf16_t* Xp, const bf16_t* Wf  , const float* rstd, const float* bfor, float* logfT) {
    const int tid = tid_opaque(), lane = tid & 63, fr = lane & 15, fq = lane >> 4; const int wave = __builtin_amdgcn_readfirstlane(tid >> 6);
    const int NBLK = (MM + NB * META) / 16;
    for (int blk = blockIdx.x * 8 + wave; blk < NBLK; blk += gridDim.x * 8) {
        f32x4 acc = (f32x4){0.f, 0.f, 0.f, 0.f};
        const bf16_t* ap = Xp + (size_t)(16 * blk + fr) * DM + 8 * fq; const bf16_t* bp = Wf + (size_t)fr * DM + 8 * fq;
#pragma unroll 8
        for (int st = 0; st < DM / 32; ++st) { const bf16x8 bv = *(const bf16x8*)(bp + 32 * st), av = *(const bf16x8*)(ap + 32 * st);
            acc = __builtin_amdgcn_mfma_f32_16x16x32_bf16(bv, av, acc, 0, 0, 0); }
        const int c = 16 * blk + fr; const float rs = rstd[c];
        const int nrow = c < MM ? c + META * ((c >> 13) + 1) : ((c - MM) >> 4) * TT + ((c - MM) & 15);
#pragma unroll
        for (int i = 0; i < 4; ++i) { const int h = 4 * fq + i; const float x = acc[i] * rs + bfor[h];
            logfT[(size_t)h * MP + nrow] = fminf(x, 0.f) - __logf(1.0f + __expf(-fabsf(x))); }
    }
}
struct EpiPlainM {
    bf16_t* O;
    static constexpr int NBB = 1;
    __device__ __forceinline__ int nunits() const { return DM / 16; }
    __device__ __forceinline__ int brow(int u, int nb) const { return 16 * u; }
    __device__ __forceinline__ void operator()(const f32x4 (&a)[1], int u, int rb, int fr, int fq) const {
        *(u32x2*)(O + (size_t)(MM + 16 * rb + fr) * DM + 16 * u + 4 * fq) = (u32x2){pg8::cvt_pk_bf16(a[0][0], a[0][1]), pg8::cvt_pk_bf16(a[0][2], a[0][3])};
    }
};
struct EpiSwigluM {
    bf16_t* O; const float* rstd;
    static constexpr int NBB = 2;
    __device__ __forceinline__ int nunits() const { return DFF / 16; }
    __device__ __forceinline__ int brow(int u, int nb) const { const int ch = 16 * u; return (ch >> 7) * 256 + nb * 128 + (ch & 127); }
    __device__ __forceinline__ void operator()(const f32x4 (&a)[2], int u, int rb, int fr, int fq) const {
        f32x4 r;
        const float rs = rstd[MM + 16 * rb + fr];
#pragma unroll
        for (int i = 0; i < 4; ++i) { const float g = a[0][i] * rs; r[i] = g * pg8::sigmoidf_(g) * (a[1][i] * rs); }
        *(u32x2*)(O + (size_t)(MM + 16 * rb + fr) * DFF + 16 * u + 4 * fq) = (u32x2){pg8::cvt_pk_bf16(r[0], r[1]), pg8::cvt_pk_bf16(r[2], r[3])};
    }
};
template <int K, class Epi>
__device__ __forceinline__ void phase(LAS unsigned char* lds, const bf16_t* A, const bf16_t* Bt, const Epi& E, int ubase, int ustride) {
    if ((int)blockIdx.x < ubase) return;
    constexpr int NBB = Epi::NBB;
    const int tid = tid_opaque(), lane = tid & 63, fr = lane & 15, fq = lane >> 4; const int wave = __builtin_amdgcn_readfirstlane(tid >> 6);
    constexpr int ksteps = K / 256;
    LAS f32x4* red = (LAS f32x4*)lds;
    const int nu = E.nunits();
    for (int u = (int)blockIdx.x - ubase; u < nu; u += ustride) {
        f32x4 acc[NBB][4];
#pragma unroll
        for (int nb = 0; nb < NBB; ++nb)
#pragma unroll
            for (int rb = 0; rb < 4; ++rb) acc[nb][rb] = (f32x4){0.f, 0.f, 0.f, 0.f};
        const bf16_t* ap = A + (size_t)fr * K + wave * ksteps * 32 + 8 * fq;
        const bf16_t* bp0 = Bt + (size_t)(E.brow(u, 0) + fr) * K + wave * ksteps * 32 + 8 * fq;
        const bf16_t* bp1 = Bt + (size_t)(E.brow(u, NBB - 1) + fr) * K + wave * ksteps * 32 + 8 * fq;
#pragma unroll
        for (int st = 0; st < ksteps; ++st) {
            const bf16x8 b0 = *(const bf16x8*)(bp0 + 32 * st); bf16x8 b1; if (NBB == 2) b1 = *(const bf16x8*)(bp1 + 32 * st);
#pragma unroll
            for (int rb = 0; rb < 4; ++rb) { const bf16x8 a = *(const bf16x8*)(ap + (size_t)(16 * rb) * K + 32 * st);
                acc[0][rb] = __builtin_amdgcn_mfma_f32_16x16x32_bf16(b0, a, acc[0][rb], 0, 0, 0);
                if (NBB == 2) acc[NBB - 1][rb] = __builtin_amdgcn_mfma_f32_16x16x32_bf16(b1, a, acc[NBB - 1][rb], 0, 0, 0); }
        }
        __syncthreads();
#pragma unroll
        for (int nb = 0; nb < NBB; ++nb)
#pragma unroll
            for (int rb = 0; rb < 4; ++rb) red[(wave * (NBB * 4) + nb * 4 + rb) * 64 + lane] = acc[nb][rb];
        __syncthreads();
        if (wave < 4) { f32x4 sum[NBB];
#pragma unroll
            for (int nb = 0; nb < NBB; ++nb) { sum[nb] = red[(nb * 4 + wave) * 64 + lane];
#pragma unroll
                for (int w = 1; w < 8; ++w) sum[nb] = sum[nb] + red[(w * (NBB * 4) + nb * 4 + wave) * 64 + lane]; }
            E(sum, u, wave, fr, fq); }
    }
    __syncthreads();
}
}

__device__ __forceinline__ void tr_item(const float* src, int ldw, int nvalid, bf16_t* dst, int ldk, LAS float* scr, int lane, const float* gk = nullptr) {
    { const int kr = lane >> 3, n4 = 4 * (lane & 7);
      f32x4 v[8];
#pragma unroll
      for (int i = 0; i < 8; ++i) { const int kk = 8 * i + kr; v[i] = (n4 < nvalid) ? *(const f32x4*)(src + (size_t)kk * ldw + n4) : (f32x4){0.f, 0.f, 0.f, 0.f}; }
#pragma unroll
      for (int i = 0; i < 8; ++i) { const int kk = 8 * i + kr; const float gsc = gk ? gk[kk] : 1.0f; LAS float* d = scr + kk * 33 + n4;
          d[0] = v[i].x * gsc; d[1] = v[i].y * gsc; d[2] = v[i].z * gsc; d[3] = v[i].w * gsc; } }
    asm volatile("s_waitcnt lgkmcnt(0)" ::: "memory");
    const int c = lane & 7;
#pragma unroll
    for (int j = 0; j < 4; ++j) { const int n = (lane >> 3) + 8 * j; const LAS float* s = scr + (8 * c) * 33 + n;
        u32x4 o; o.x = pk2(s[0 * 33], s[1 * 33]); o.y = pk2(s[2 * 33], s[3 * 33]); o.z = pk2(s[4 * 33], s[5 * 33]); o.w = pk2(s[6 * 33], s[7 * 33]);
        *(u32x4*)(dst + (size_t)n * ldk + 8 * c) = o; }
    asm volatile("s_waitcnt lgkmcnt(0)" ::: "memory");
}

constexpr int CV_SEG = 16 * 32, CV_F = 16, CV_FF = 16 * 88, CV_DN = 44 * 32;
constexpr int CV_Z = 256, CV_IN8 = (5 * CV_SEG + CV_F) / 8, CV_REST8 = (CV_SEG + 2 * CV_FF + CV_DN) / 8;
static_assert(CV_IN8 * 8 == 5 * CV_SEG + CV_F && CV_REST8 * 8 == CV_SEG + 2 * CV_FF + CV_DN, "wave items per workgroup item");
__device__ __forceinline__ void conv_z_item(KP p, int l, int item, LAS unsigned char* lds) {
    const int tid = tid_opaque(), lane = tid & 63, fr = lane & 15, fq = lane >> 4; const int wave = __builtin_amdgcn_readfirstlane(tid >> 6);
    bf16_t* Wt_in = (bf16_t*)(p->ws + WS_WIN); const float* w_in = p->w_in + (size_t)l * DM * NIN_SRC;
    const int g = item >> 6, kb = (item >> 2) & 15, db = item & 3, k0 = kb * 64 + 32 * (wave >> 2), d0 = db * 64 + 16 * (wave & 3);
    const float* wp = p->w_pool + ((size_t)(l * 4 + g) * 256) * 256 + d0 + fr;
    const float* y0 = w_in + (size_t)(k0 + fr) * NIN_SRC + g * 256 + 8 * fq;
    const float* y1 = y0 + (size_t)16 * NIN_SRC;
    const float g0 = p->n_mix_pre[l * DM + k0 + fr], g1 = p->n_mix_pre[l * DM + k0 + 16 + fr];
    f32x4 acc0 = (f32x4){0.f, 0.f, 0.f, 0.f}, acc1 = acc0;
#pragma unroll 4
    for (int st = 0; st < 8; ++st) {
        const int c0 = 32 * st;
        float xf[8];
#pragma unroll
        for (int i = 0; i < 8; ++i) xf[i] = wp[(size_t)(c0 + 8 * fq + i) * 256];
        const f32x4 a0 = *(const f32x4*)(y0 + c0), a1 = *(const f32x4*)(y0 + c0 + 4), b0 = *(const f32x4*)(y1 + c0), b1 = *(const f32x4*)(y1 + c0 + 4);
        const u32x4 xw = (u32x4){cvtpk_s(xf[0], xf[1]), cvtpk_s(xf[2], xf[3]), cvtpk_s(xf[4], xf[5]), cvtpk_s(xf[6], xf[7])};
        const u32x4 yw0 = (u32x4){cvtpk_s(a0.x * g0, a0.y * g0), cvtpk_s(a0.z * g0, a0.w * g0), cvtpk_s(a1.x * g0, a1.y * g0), cvtpk_s(a1.z * g0, a1.w * g0)};
        const u32x4 yw1 = (u32x4){cvtpk_s(b0.x * g1, b0.y * g1), cvtpk_s(b0.z * g1, b0.w * g1), cvtpk_s(b1.x * g1, b1.y * g1), cvtpk_s(b1.z * g1, b1.w * g1)};
        acc0 = __builtin_amdgcn_mfma_f32_16x16x32_bf16(__builtin_bit_cast(bf16x8, xw), __builtin_bit_cast(bf16x8, yw0), acc0, 0, 0, 0);
        acc1 = __builtin_amdgcn_mfma_f32_16x16x32_bf16(__builtin_bit_cast(bf16x8, xw), __builtin_bit_cast(bf16x8, yw1), acc1, 0, 0, 0);
    }
#pragma unroll
    for (int i = 0; i < 4; ++i) { bf16_t* o = Wt_in + (size_t)(g * 256 + d0 + 4 * fq + i) * DM + k0 + fr;
        o[0] = (bf16_t)f2bf(acc0[i]); o[16] = (bf16_t)f2bf(acc1[i]); }
}
__device__ __forceinline__ void conv_tr_in(KP p, int l, int r, LAS float* scr, int lane) {
    bf16_t* Wt_in = (bf16_t*)(p->ws + WS_WIN); const float* w_in = p->w_in + (size_t)l * DM * NIN_SRC;
    if (r < 5 * CV_SEG) { const int seg = r / CV_SEG; r -= seg * CV_SEG; const int kb = r >> 5, nb = r & 31;
        const int srccol = (seg < 3 ? 1024 * (seg + 1) : 4112 + 1024 * (seg - 3)) + 32 * nb;
        tr_item(w_in + (size_t)(64 * kb) * NIN_SRC + srccol, NIN_SRC, 32, Wt_in + (size_t)(1024 * (seg + 1) + 32 * nb) * DM + 64 * kb, DM, scr, lane, p->n_mix_pre + l * DM + 64 * kb);
    } else { r -= 5 * CV_SEG; tr_item(w_in + (size_t)(64 * r) * NIN_SRC + 4096, NIN_SRC, 16, Wt_in + (size_t)6144 * DM + 64 * r, DM, scr, lane, p->n_mix_pre + l * DM + 64 * r); }
}
__device__ __forceinline__ void conv_tr_rest(KP p, int l, int r, LAS float* scr, int lane) {
    bf16_t* Wt_out = (bf16_t*)(p->ws + WS_WOUT); bf16_t* Wt_gu = (bf16_t*)(p->ws + WS_WGU); bf16_t* Wt_dn = (bf16_t*)(p->ws + WS_WDN);
    if (r < CV_SEG) { const int kb = r >> 5, nb = r & 31;
        tr_item(p->w_out + (size_t)l * DM * DM + (size_t)(64 * kb) * DM + 32 * nb, DM, 32, Wt_out + (size_t)(32 * nb) * DM + 64 * kb, DM, scr, lane);
    } else if (r < CV_SEG + 2 * CV_FF) { r -= CV_SEG; const int up = r >= CV_FF; if (up) r -= CV_FF; const int kb = r / 88, nb = r % 88; const int n0 = 32 * nb;
        const float* W = (up ? p->w_up : p->w_gate) + (size_t)l * DM * DFF;
        const int drow = (n0 >> 7) * 256 + (up ? 128 : 0) + (n0 & 127);
        tr_item(W + (size_t)(64 * kb) * DFF + n0, DFF, 32, Wt_gu + (size_t)drow * DM + 64 * kb, DM, scr, lane, p->n_ffn_pre + l * DM + 64 * kb);
    } else { r -= CV_SEG + 2 * CV_FF; const int kb = r >> 5, nb = r & 31;
        tr_item(p->w_down + (size_t)l * DFF * DM + (size_t)(64 * kb) * DM + 32 * nb, DM, 32, Wt_dn + (size_t)(32 * nb) * DFF + 64 * kb, DFF, scr, lane); }
}
__device__ __forceinline__ int conv_count(int l_in, bool rest) { return (l_in < DEPTH ? CV_Z + CV_IN8 : 0) + (rest ? CV_REST8 : 0); }
__device__ __forceinline__ void conv_wg_item(KP p, int l_in, int l_rest, int ci, LAS unsigned char* lds) {
    const int tid = tid_opaque(), lane = tid & 63, wave = tid >> 6;
    LAS float* scr = (LAS float*)(lds + wave * 16384);
    const int nin = (l_in < DEPTH) ? CV_Z + CV_IN8 : 0;
    if (ci < nin) { if (ci < CV_Z) conv_z_item(p, l_in, ci, lds); else conv_tr_in(p, l_in, (ci - CV_Z) * 8 + wave, scr, lane); }
    else conv_tr_rest(p, l_rest, (ci - nin) * 8 + wave, scr, lane);
    __syncthreads();
}

template <int MODE, bool DRY = false>
__device__ __forceinline__ void norm_pass(KP p, const float* g_post) {
    const int tid_ = tid_opaque(); const int lane = tid_ & 63, wave = tid_ >> 6;
    const int gw = blockIdx.x * 8 + wave, NGW = gridDim.x * 8;
    const bf16_t* mix = (const bf16_t*)(p->ws + WS_MIX); bf16_t* X = (bf16_t*)(p->ws + WS_HB); float* rstdA = (float*)(p->ws + WS_RSTD) + (DRY ? 65536 : 0);
    bf16_t* Xw = DRY ? (bf16_t*)(p->ws + WS_Z) : X;
    constexpr int RB = 4;
    f32x4 gpo[4];
#pragma unroll
    for (int j = 0; j < 4; ++j) gpo[j] = (MODE != 0) ? ((const f32x4*)g_post)[lane + 64 * j] : (f32x4){0.f, 0.f, 0.f, 0.f};
    for (int r0 = gw; r0 < MREAL; r0 += RB * NGW) {
        f32x4 v[RB][4]; u32x2 mw[RB][4], xw[RB][4]; bool ok[RB]; int cr[RB], bb[RB], tt[RB];
#pragma unroll
        for (int i = 0; i < RB; ++i) { const int r = r0 + i * NGW; ok[i] = r < MREAL; const int rr = ok[i] ? r : r0; bb[i] = rr / TT; tt[i] = rr - bb[i] * TT; cr[i] = compact_row(bb[i], tt[i]);
            if (MODE == 0) { const float* src = tt[i] < META ? p->meta + (size_t)tt[i] * DM : p->x + ((size_t)bb[i] * SEQ + (tt[i] - META)) * DM;
#pragma unroll
                for (int j = 0; j < 4; ++j) v[i][j] = ((const f32x4*)src)[lane + 64 * j];
            } else { const u32x2* mr = (const u32x2*)(mix + (size_t)cr[i] * DM); const u32x2* xr = (const u32x2*)(X + (size_t)cr[i] * DM);
#pragma unroll
                for (int j = 0; j < 4; ++j) { mw[i][j] = mr[lane + 64 * j]; xw[i][j] = xr[lane + 64 * j]; } } }
        if (MODE != 0) {
            float ss[RB];
#pragma unroll
            for (int i = 0; i < RB; ++i) { ss[i] = 0.f;
#pragma unroll
                for (int j = 0; j < 4; ++j) { const float a = bf_lo(mw[i][j].x), b = bf_hi(mw[i][j].x), c = bf_lo(mw[i][j].y), d = bf_hi(mw[i][j].y); ss[i] += (a * a + b * b) + (c * c + d * d); } }
#pragma unroll
            for (int o = 1; o < 64; o <<= 1) {
#pragma unroll
                for (int i = 0; i < RB; ++i) ss[i] += __shfl_xor(ss[i], o); }
#pragma unroll
            for (int i = 0; i < RB; ++i) { const float rstd = 1.0f / sqrtf(ss[i] * (1.0f / DM) + RMS_EPS);
#pragma unroll
                for (int j = 0; j < 4; ++j) { const f32x4 mx = (f32x4){bf_lo(mw[i][j].x), bf_hi(mw[i][j].x), bf_lo(mw[i][j].y), bf_hi(mw[i][j].y)};
                    const f32x4 xo = (f32x4){bf_lo(xw[i][j].x), bf_hi(xw[i][j].x), bf_lo(xw[i][j].y), bf_hi(xw[i][j].y)}; v[i][j] = xo + mx * rstd * gpo[j]; } }
        }
        if (MODE == 2) {
#pragma unroll
            for (int i = 0; i < RB; ++i) { if (ok[i] && tt[i] >= META) { f32x4* o = (f32x4*)(p->out + ((size_t)bb[i] * SEQ + (tt[i] - META)) * DM);
#pragma unroll
                for (int j = 0; j < 4; ++j) o[lane + 64 * j] = v[i][j]; } }
        } else {
            float s2[RB];
#pragma unroll
            for (int i = 0; i < RB; ++i) { s2[i] = 0.f; u32x2* o = (u32x2*)(Xw + (size_t)cr[i] * DM);
#pragma unroll
                for (int j = 0; j < 4; ++j) { const u32x2 w = (u32x2){pk2(v[i][j].x, v[i][j].y), pk2(v[i][j].z, v[i][j].w)};
                    const float a = bf_lo(w.x), b = bf_hi(w.x), c = bf_lo(w.y), d = bf_hi(w.y); s2[i] += (a * a + b * b) + (c * c + d * d);
                    if (ok[i]) o[lane + 64 * j] = w; } }
#pragma unroll
            for (int o = 1; o < 64; o <<= 1) {
#pragma unroll
                for (int i = 0; i < RB; ++i) s2[i] += __shfl_xor(s2[i], o); }
#pragma unroll
            for (int i = 0; i < RB; ++i) { if (ok[i] && lane == 0) rstdA[cr[i]] = 1.0f / sqrtf(s2[i] * (1.0f / DM) + RMS_EPS); }
        }
    }
}

__device__ __forceinline__ void scan_unit(KP p, int bh, LAS unsigned char* lds) {
    const int tid = tid_opaque(), lane = tid & 63, wave = tid >> 6;
    const int b = bh >> 4, h = bh & 15;
    const float* src = (const float*)(p->ws + WS_LOGF) + (size_t)h * MP + (size_t)b * TT;
    float* dst = (float*)(p->ws + WS_FB) + (size_t)bh * TT;
    LAS float* wt = (LAS float*)lds;
    const int t0 = tid * 17;
    float v[17]; float s = 0.f;
#pragma unroll
    for (int i = 0; i < 17; ++i) { const int t = t0 + i; v[i] = (t < TT) ? src[t] : 0.f; s += v[i]; }
    float inc = s;
#pragma unroll
    for (int o = 1; o < 64; o <<= 1) { const float n = __shfl_up(inc, o); if (lane >= o) inc += n; }
    __syncthreads();
    if (lane == 63) wt[wave] = inc;
    __syncthreads();
    float pre = inc - s;
#pragma unroll
    for (int w = 0; w < 8; ++w) if (w < wave) pre += wt[w];
#pragma unroll
    for (int i = 0; i < 17; ++i) { const int t = t0 + i; pre += v[i]; if (t < TT) dst[t] = -pre * LOG2E; }
    __syncthreads();
}

__device__ __forceinline__ void poolgate_phase(KP p, int l) {
    const int gid = blockIdx.x * 512 + tid_opaque();
    constexpr int RUN = 36, NRUN = TT / RUN;
    static_assert(NRUN * RUN == TT, "runs");
    const bf16_t* Z = (const bf16_t*)(p->ws + WS_Z); const bf16_t* SGP = (const bf16_t*)(p->ws + WS_Z + 4 * SLOT); bf16_t* MRG = (bf16_t*)p->out;
    for (int id = gid; id < NB * NRUN * 128; id += gridDim.x * 512) {
        const int ct = id & 127, rr = id >> 7, b = rr / NRUN, run = rr - b * NRUN;
        const int t0 = run * RUN;
        const int c0 = ct * 8, g = c0 >> 8, w = 2 << g;
        const bf16_t* Zc = Z + (size_t)b * TT * DM + c0; const bf16_t* Gc = SGP + (size_t)b * TT * DM + c0; bf16_t* Mc = MRG + c0;
        float sc[8];
        { const f32x4 a = *(const f32x4*)(p->pool_scale + (size_t)l * DM + c0), bq = *(const f32x4*)(p->pool_scale + (size_t)l * DM + c0 + 4);
          sc[0] = a.x; sc[1] = a.y; sc[2] = a.z; sc[3] = a.w; sc[4] = bq.x; sc[5] = bq.y; sc[6] = bq.z; sc[7] = bq.w; }
        float sum[8];
#pragma unroll
        for (int i = 0; i < 8; ++i) sum[i] = 0.f;
#define PG_ACC(S_, zv) do { sum[0] S_ bf_lo(zv.x); sum[1] S_ bf_hi(zv.x); sum[2] S_ bf_lo(zv.y); sum[3] S_ bf_hi(zv.y); sum[4] S_ bf_lo(zv.z); sum[5] S_ bf_hi(zv.z); sum[6] S_ bf_lo(zv.w); sum[7] S_ bf_hi(zv.w); } while (0)
        { u32x4 hz[15];
#pragma unroll
          for (int i = 0; i < 15; ++i) { const int t = t0 - 15 + i; hz[i] = *(const u32x4*)(Zc + (size_t)(t > 0 ? t : 0) * DM); }
#pragma unroll
          for (int i = 0; i < 15; ++i) { const int t = t0 - 15 + i; if (t >= 0 && t > t0 - w) PG_ACC(+=, hz[i]); } }
        for (int tb = t0; tb < t0 + RUN; tb += 4) {
            u32x4 zv[4], gv[4], zo[4];
#pragma unroll
            for (int i = 0; i < 4; ++i) { const int t = tb + i; const int tl = t - w + 1;
                zv[i] = *(const u32x4*)(Zc + (size_t)t * DM); gv[i] = *(const u32x4*)(Gc + (size_t)t * DM); zo[i] = *(const u32x4*)(Zc + (size_t)(tl > 0 ? tl : 0) * DM); }
#pragma unroll
            for (int i = 0; i < 4; ++i) { const int t = tb + i; const int tl = t - w + 1;
                const float zz[8] = {bf_lo(zv[i].x), bf_hi(zv[i].x), bf_lo(zv[i].y), bf_hi(zv[i].y), bf_lo(zv[i].z), bf_hi(zv[i].z), bf_lo(zv[i].w), bf_hi(zv[i].w)};
                const float gg[8] = {bf_lo(gv[i].x), bf_hi(gv[i].x), bf_lo(gv[i].y), bf_hi(gv[i].y), bf_lo(gv[i].z), bf_hi(gv[i].z), bf_lo(gv[i].w), bf_hi(gv[i].w)};
                const float inv = 1.0f / (float)((t + 1 < w) ? t + 1 : w);
                float y[8];
#pragma unroll
                for (int e = 0; e < 8; ++e) { sum[e] += zz[e]; y[e] = (sum[e] * inv - zz[e]) * sc[e] * gg[e]; }
                u32x4 o; o.x = pk2(y[0], y[1]); o.y = pk2(y[2], y[3]); o.z = pk2(y[4], y[5]); o.w = pk2(y[6], y[7]);
                *(u32x4*)(Mc + (size_t)compact_row(b, t) * DM) = o;
                if (tl >= 0) PG_ACC(-=, zo[i]); }
        }
#undef PG_ACC
    }
}

constexpr int CW_NORM = 512;
__device__ __forceinline__ void qknorm_phase(KP p, int l, LAS unsigned char* lds) {
    const int tid = tid_opaque(), lane = tid & 63, wave = tid >> 6;
    LAS unsigned* tab = (LAS unsigned*)(lds + 1024);
    if (tid < 64) tab[tid] = 0u;
    __syncthreads();
    const bf16_t* Qg = (const bf16_t*)(p->ws + WS_Z + 1 * SLOT); const bf16_t* Kg = (const bf16_t*)(p->ws + WS_Z + 2 * SLOT);
    const int r0 = blockIdx.x * 129, r1 = (r0 + 129 < MREAL) ? r0 + 129 : MREAL;
    const int b0 = r0 / TT;
    float mq0 = 0.f, mk0 = 0.f, mq1 = 0.f, mk1 = 0.f;
#define SQ2(w) (bf_lo(w) * bf_lo(w) + bf_hi(w) * bf_hi(w))
    for (int rb_ = r0 + wave; rb_ < r1; rb_ += 32) {
        u32x4 qa[4], qb[4], ka[4], kb[4];
#pragma unroll
        for (int i = 0; i < 4; ++i) { const int r = (rb_ + 8 * i < r1) ? rb_ + 8 * i : rb_;
            const u32x4* qp = (const u32x4*)(Qg + (size_t)r * DM) + 2 * lane; const u32x4* kp = (const u32x4*)(Kg + (size_t)r * DM) + 2 * lane;
            qa[i] = qp[0]; qb[i] = qp[1]; ka[i] = kp[0]; kb[i] = kp[1]; }
#pragma unroll
        for (int i = 0; i < 4; ++i) { const int r = rb_ + 8 * i;
            float sq = (SQ2(qa[i].x) + SQ2(qa[i].y)) + (SQ2(qa[i].z) + SQ2(qa[i].w)) + (SQ2(qb[i].x) + SQ2(qb[i].y)) + (SQ2(qb[i].z) + SQ2(qb[i].w));
            float sk = (SQ2(ka[i].x) + SQ2(ka[i].y)) + (SQ2(ka[i].z) + SQ2(ka[i].w)) + (SQ2(kb[i].x) + SQ2(kb[i].y)) + (SQ2(kb[i].z) + SQ2(kb[i].w));
            sq += __shfl_xor(sq, 1); sq += __shfl_xor(sq, 2); sk += __shfl_xor(sk, 1); sk += __shfl_xor(sk, 2);
            if (r < r1) { if (r / TT == b0) { mq0 = fmaxf(mq0, sq); mk0 = fmaxf(mk0, sk); } else { mq1 = fmaxf(mq1, sq); mk1 = fmaxf(mk1, sk); } } }
    }
#undef SQ2
    if ((lane & 3) == 0) { const int h = lane >> 2;
        __hip_atomic_fetch_max(tab + h, __builtin_bit_cast(unsigned, mq0), __ATOMIC_RELAXED, __HIP_MEMORY_SCOPE_WORKGROUP);
        __hip_atomic_fetch_max(tab + 16 + h, __builtin_bit_cast(unsigned, mk0), __ATOMIC_RELAXED, __HIP_MEMORY_SCOPE_WORKGROUP);
        __hip_atomic_fetch_max(tab + 32 + h, __builtin_bit_cast(unsigned, mq1), __ATOMIC_RELAXED, __HIP_MEMORY_SCOPE_WORKGROUP);
        __hip_atomic_fetch_max(tab + 48 + h, __builtin_bit_cast(unsigned, mk1), __ATOMIC_RELAXED, __HIP_MEMORY_SCOPE_WORKGROUP); }
    __syncthreads();
    if (tid < 64) { const int b = b0 + (tid >> 5); const unsigned v = tab[tid];
        if (b < NB && v != 0u) __hip_atomic_fetch_max((unsigned*)(p->ws + WS_CTL) + CW_NORM + ((l * NB + b) * 2 + ((tid >> 4) & 1)) * NH + (tid & 15), v, __ATOMIC_RELAXED, __HIP_MEMORY_SCOPE_AGENT); }
    __syncthreads();
}

namespace att {
constexpr int L_B = 32768, L_WS = 33280, L_OST = 36864, L_Q = 69632;
__device__ __forceinline__ int crow(int r, int hi) { return (r & 3) + 8 * (r >> 2) + 4 * hi; }
__device__ __forceinline__ float max3f(float a, float b, float c) { float r; asm("v_max3_f32 %0, %1, %2, %3" : "=v"(r) : "v"(a), "v"(b), "v"(c)); return r; }
__device__ __forceinline__ float max2f(float a, float b) { float r; asm("v_max_f32_e32 %0, %1, %2" : "=v"(r) : "v"(a), "v"(b)); return r; }
typedef short v4i16_t __attribute__((ext_vector_type(4)));
__device__ __forceinline__ s16x4 vtr(const LAS unsigned char* p) { return __builtin_bit_cast(s16x4, __builtin_amdgcn_ds_read_tr16_b64_v4i16((LAS v4i16_t*)p)); }

__device__ __forceinline__ void attn_unit(int b, int h, int q0, int nrows, const bf16_t* Qg, const bf16_t* Kg, const bf16_t* Vg, const bf16_t* SGA, bf16_t* MRG,
                                          const float* FBbh, float skipB, bool dostore, LAS unsigned char* shm) {
    const int tid = tid_opaque(), lane = tid & 63, r32 = lane & 31, hi = lane >> 5; const int wid = __builtin_amdgcn_readfirstlane(tid >> 6);
    const size_t rowbase = (size_t)b * TT;
    const int qw0 = q0 + 32 * wid, lastq = q0 + nrows - 1, NT = lastq / 64 + 1;
    const bool wact = (32 * wid < nrows);
    const int qabs = qw0 + r32;
    bf16x8 qr[4];
    { const int qrow = qabs < TT ? qabs : TT - 1; const bf16_t* qp = Qg + (rowbase + qrow) * DM + h * HD + hi * 8;
#pragma unroll
      for (int d0 = 0; d0 < 4; ++d0) qr[d0] = *(const bf16x8*)(qp + d0 * 16); }
    const bf16_t* ksrc = Kg + (rowbase + lane) * DM + h * HD + wid * 8;
    const bf16_t* vsrc = Vg + (rowbase + 16 * (wid & 3) + (lane >> 2)) * DM + h * HD + (wid >> 2) * 32 + (lane & 3) * 8;
    const unsigned stoff = (unsigned)wid * 1024u + (unsigned)lane * 16u;
    int j0;
    { LAS unsigned* wc = (LAS unsigned*)(shm + L_Q + 64);
      const float limit = FBbh[q0] - skipB;
      bool pred = false;
      if (tid < NT) { const int ke = 64 * tid + 63; pred = FBbh[ke < TT ? ke : TT - 1] < limit; }
      const unsigned long long bal = __ballot(pred);
      if (lane == 0) wc[wid] = (unsigned)__popcll(bal);
      __syncthreads();
      j0 = (int)(wc[0] + wc[1] + wc[2]);
      if (j0 > NT - 1) j0 = NT - 1; }
    u32x4 kreg = *(const u32x4*)(ksrc + (size_t)j0 * 64 * DM), vreg = *(const u32x4*)(vsrc + (size_t)j0 * 64 * DM); float breg = (tid < 64) ? FBbh[j0 * 64 + tid] : 0.f;
    { const int nb0 = (j0 & 1) * 16384; *(LAS u32x4*)(shm + nb0 + stoff) = kreg; *(LAS u32x4*)(shm + nb0 + 8192 + stoff) = vreg; if (tid < 64) ((LAS float*)(shm + L_B + (j0 & 1) * 256))[tid] = breg; }
    if (j0 + 1 < NT) { kreg = *(const u32x4*)(ksrc + (size_t)(j0 + 1) * 64 * DM); vreg = *(const u32x4*)(vsrc + (size_t)(j0 + 1) * 64 * DM); if (tid < 64) breg = FBbh[(j0 + 1) * 64 + tid]; }
    u32x4 kreg2 = kreg, vreg2 = vreg; float breg2 = breg;
    __syncthreads();
    float m = NEGBIG, l = 0.f; f32x16 o0, o1;
#pragma unroll
    for (int r = 0; r < 16; ++r) { o0[r] = 0.f; o1[r] = 0.f; }
    LAS float* wsf = (LAS float*)(shm + L_WS + wid * 256);
    for (int jj = j0; jj < NT; jj += 2) {
#pragma unroll
      for (int half = 0; half < 2; ++half) {
        const int j = jj + half; if (j >= NT) break;
        const int cur = j & 1; const bool more = (j + 1 < NT);
        if (j + 2 < NT) {
            if (half == 0) { kreg2 = *(const u32x4*)(ksrc + (size_t)(j + 2) * 64 * DM); vreg2 = *(const u32x4*)(vsrc + (size_t)(j + 2) * 64 * DM); if (tid < 64) breg2 = FBbh[(j + 2) * 64 + tid]; }
            else           { kreg  = *(const u32x4*)(ksrc + (size_t)(j + 2) * 64 * DM); vreg  = *(const u32x4*)(vsrc + (size_t)(j + 2) * 64 * DM); if (tid < 64) breg  = FBbh[(j + 2) * 64 + tid]; } }
        if (wact && 64 * j <= qw0 + 31) {
            const LAS unsigned char* Kb = shm + cur * 16384; const LAS unsigned char* Vb = Kb + 8192; const LAS float* bias = (const LAS float*)(shm + L_B + cur * 256);
            f32x16 p0, p1;
#pragma unroll
            for (int g = 0; g < 4; ++g) { const f32x4 a = *(const LAS f32x4*)(bias + 8 * g + 4 * hi), c = *(const LAS f32x4*)(bias + 32 + 8 * g + 4 * hi);
                p0[4 * g] = a.x; p0[4 * g + 1] = a.y; p0[4 * g + 2] = a.z; p0[4 * g + 3] = a.w; p1[4 * g] = c.x; p1[4 * g + 1] = c.y; p1[4 * g + 2] = c.z; p1[4 * g + 3] = c.w; }
            const LAS unsigned char* kb = Kb + hi * 1024 + r32 * 16;
#pragma unroll
            for (int d0 = 0; d0 < 4; ++d0) { const bf16x8 b0 = *(const LAS bf16x8*)(kb + d0 * 2048), b1 = *(const LAS bf16x8*)(kb + d0 * 2048 + 512);
                p0 = __builtin_amdgcn_mfma_f32_32x32x16_bf16(b0, qr[d0], p0, 0, 0, 0); p1 = __builtin_amdgcn_mfma_f32_32x32x16_bf16(b1, qr[d0], p1, 0, 0, 0); }
            asm volatile("s_nop 15\n\ts_nop 7" : "+v"(p0), "+v"(p1));
            if (64 * j + 63 > qw0) {
                const int kbase = 64 * j + 4 * hi;
#pragma unroll
                for (int r = 0; r < 16; ++r) { const int kv = kbase + (r & 3) + 8 * (r >> 2); if (kv > qabs) p0[r] = NEGBIG; if (kv + 32 > qabs) p1[r] = NEGBIG; }
            }
            float ta = max3f(p0[0], p0[1], p1[0]), tb = max3f(p0[2], p0[3], p1[1]); ta = max3f(ta, p1[2], p1[3]);
#pragma unroll
            for (int r = 4; r < 16; r += 4) { ta = max3f(ta, p0[r], p0[r + 1]); tb = max3f(tb, p0[r + 2], p0[r + 3]); ta = max3f(ta, p1[r], p1[r + 1]); tb = max3f(tb, p1[r + 2], p1[r + 3]); }
            float tmax = max2f(ta, tb);
            { auto rr_ = __builtin_amdgcn_permlane32_swap(__float_as_uint(tmax), __float_as_uint(tmax), false, false);
              tmax = max2f(__uint_as_float(rr_[0]), __uint_as_float(rr_[1])); }
            const bool grow = __any(tmax > m + 8.0f);
            if (grow) {
                const float mn = max2f(m, tmax); const float alpha = __builtin_amdgcn_exp2f(m - mn); m = mn; l *= alpha;
                if (hi == 0) wsf[r32] = alpha;
            }
            p0 = p0 - m; p1 = p1 - m;
#pragma unroll
            for (int r = 0; r < 16; ++r) { p0[r] = __builtin_amdgcn_exp2f(p0[r]); p1[r] = __builtin_amdgcn_exp2f(p1[r]); }
            { const f32x16 ps = p0 + p1;
              l += ((ps[0] + ps[1]) + (ps[2] + ps[3])) + ((ps[4] + ps[5]) + (ps[6] + ps[7])) + (((ps[8] + ps[9]) + (ps[10] + ps[11])) + ((ps[12] + ps[13]) + (ps[14] + ps[15]))); }
            u32x4 pw0, pw1, pw2, pw3;
            pw0 = (u32x4){cvtpk_s(p0[0], p0[1]), cvtpk_s(p0[2], p0[3]), cvtpk_s(p0[4], p0[5]), cvtpk_s(p0[6], p0[7])};
            pw1 = (u32x4){cvtpk_s(p0[8], p0[9]), cvtpk_s(p0[10], p0[11]), cvtpk_s(p0[12], p0[13]), cvtpk_s(p0[14], p0[15])};
            pw2 = (u32x4){cvtpk_s(p1[0], p1[1]), cvtpk_s(p1[2], p1[3]), cvtpk_s(p1[4], p1[5]), cvtpk_s(p1[6], p1[7])};
            pw3 = (u32x4){cvtpk_s(p1[8], p1[9]), cvtpk_s(p1[10], p1[11]), cvtpk_s(p1[12], p1[13]), cvtpk_s(p1[14], p1[15])};
            if (grow) {
#pragma unroll
                for (int g = 0; g < 4; ++g) { const f32x4 a = *(const LAS f32x4*)(wsf + 8 * g + 4 * hi);
                    o0[4 * g] *= a.x; o0[4 * g + 1] *= a.y; o0[4 * g + 2] *= a.z; o0[4 * g + 3] *= a.w; o1[4 * g] *= a.x; o1[4 * g + 1] *= a.y; o1[4 * g + 2] *= a.z; o1[4 * g + 3] *= a.w; }
            }
            const LAS unsigned char* vp = Vb + ((lane >> 4) & 1) * 32 + (lane & 3) * 8 + (4 * hi + ((lane & 15) >> 2)) * 64;
#define ATT_PV(OD, D0, KS, PW) do { const s16x4 lo_ = vtr(vp + (D0) * 4096 + (KS) * 1024), hi_ = vtr(vp + (D0) * 4096 + (KS) * 1024 + 512); \
                const bf16x8 vf_ = (bf16x8){lo_[0], lo_[1], lo_[2], lo_[3], hi_[0], hi_[1], hi_[2], hi_[3]}; \
                OD = __builtin_amdgcn_mfma_f32_32x32x16_bf16(__builtin_bit_cast(bf16x8, PW), vf_, OD, 0, 0, 0); } while (0)
            ATT_PV(o0, 0, 0, pw0); ATT_PV(o1, 1, 0, pw0); ATT_PV(o0, 0, 1, pw1); ATT_PV(o1, 1, 1, pw1);
            ATT_PV(o0, 0, 2, pw2); ATT_PV(o1, 1, 2, pw2); ATT_PV(o0, 0, 3, pw3); ATT_PV(o1, 1, 3, pw3);
#undef ATT_PV
        }
        if (more) { const int nb = (cur ^ 1) * 16384;
            if (half == 0) { *(LAS u32x4*)(shm + nb + stoff) = kreg;  *(LAS u32x4*)(shm + nb + 8192 + stoff) = vreg;  if (tid < 64) ((LAS float*)(shm + L_B + (cur ^ 1) * 256))[tid] = breg; }
            else           { *(LAS u32x4*)(shm + nb + stoff) = kreg2; *(LAS u32x4*)(shm + nb + 8192 + stoff) = vreg2; if (tid < 64) ((LAS float*)(shm + L_B + (cur ^ 1) * 256))[tid] = breg2; } }
        __syncthreads();
      }
    }
    if (wact) {
        l += __shfl_xor(l, 32);
        if (hi == 0) wsf[r32] = 1.0f / l;
        float rli[16];
#pragma unroll
        for (int g = 0; g < 4; ++g) { const f32x4 a = *(const LAS f32x4*)(wsf + 8 * g + 4 * hi); rli[4 * g] = a.x; rli[4 * g + 1] = a.y; rli[4 * g + 2] = a.z; rli[4 * g + 3] = a.w; }
        LAS bf16_t* stg = (LAS bf16_t*)(shm + L_OST + wid * 4096);
#pragma unroll
        for (int r = 0; r < 16; ++r) { const int orow = crow(r, hi); stg[orow * 64 + r32] = (bf16_t)f2bf(o0[r] * rli[r]); stg[orow * 64 + 32 + r32] = (bf16_t)f2bf(o1[r] * rli[r]); }
        asm volatile("s_waitcnt lgkmcnt(0)" ::: "memory");
#pragma unroll
        for (int i = 0; i < 4; ++i) { const int row = i * 8 + (lane >> 3), ch = lane & 7; const int grow = qw0 + row;
            const u32x4 ov = *(const LAS u32x4*)(stg + row * 64 + ch * 8);
            if (grow <= lastq && dostore) { const size_t off = (rowbase + grow) * DM + h * HD + ch * 8; const size_t moff = (size_t)compact_row(b, grow) * DM + h * HD + ch * 8;
                const u32x4 mg = *(const u32x4*)(MRG + moff), sg = *(const u32x4*)(SGA + off); u32x4 w;
                w.x = pk2(bf_lo(mg.x) + bf_lo(sg.x) * bf_lo(ov.x), bf_hi(mg.x) + bf_hi(sg.x) * bf_hi(ov.x));
                w.y = pk2(bf_lo(mg.y) + bf_lo(sg.y) * bf_lo(ov.y), bf_hi(mg.y) + bf_hi(sg.y) * bf_hi(ov.y));
                w.z = pk2(bf_lo(mg.z) + bf_lo(sg.z) * bf_lo(ov.z), bf_hi(mg.z) + bf_hi(sg.z) * bf_hi(ov.z));
                w.w = pk2(bf_lo(mg.w) + bf_lo(sg.w) * bf_lo(ov.w), bf_hi(mg.w) + bf_hi(sg.w) * bf_hi(ov.w));
                *(u32x4*)(MRG + moff) = w; } }
    }
    __syncthreads();
}

__device__ __forceinline__ void attn_phase(KP p, int l, int pass, LAS unsigned char* shm) {
    unsigned* ctr = (unsigned*)(p->ws + WS_CTL) + 64 * (l + DEPTH * pass);
    const bool dostore = (pass == 0);
    const bf16_t* Qg = (const bf16_t*)(p->ws + WS_Z + 1 * SLOT); const bf16_t* Kg = (const bf16_t*)(p->ws + WS_Z + 2 * SLOT); const bf16_t* Vg = (const bf16_t*)(p->ws + WS_Z + 3 * SLOT);
    const bf16_t* SGA = (const bf16_t*)(p->ws + WS_Z + 5 * SLOT); bf16_t* MRG = (bf16_t*)p->out;
    const float* FB = (const float*)(p->ws + WS_FB);
    LAS unsigned* qw = (LAS unsigned*)(shm + L_Q);
    constexpr int NUNITS = 64 * 33;
    unsigned nxt = 0u;
    if (threadIdx.x == 0) nxt = __hip_atomic_fetch_add(ctr, 1u, __ATOMIC_RELAXED, __HIP_MEMORY_SCOPE_AGENT);
    for (;;) {
        if (threadIdx.x == 0) *qw = nxt;
        __syncthreads();
        const int idx = (int)*qw;
        __syncthreads();
        if (threadIdx.x == 0) nxt = __hip_atomic_fetch_add(ctr, 1u, __ATOMIC_RELAXED, __HIP_MEMORY_SCOPE_AGENT);
        if (idx >= NUNITS) {
            const int ci = idx - NUNITS;
            if (pass != 0 || ci >= conv_count(l + 1, true) * PROBE_CONV_REPS) break;
            conv_wg_item(p, l + 1, l, ci % conv_count(l + 1, true), shm);
            continue; }
        const int qb = 32 - idx / 64, bh = idx % 64;
        const int q0 = qb == 0 ? 0 : META + 256 * (qb - 1), nrows = qb == 0 ? META : 256;
        const unsigned* nt = (const unsigned*)(p->ws + WS_CTL) + CW_NORM + ((l * NB + (bh >> 4)) * 2) * NH + (bh & 15);
        const float qn2 = __builtin_bit_cast(float, nt[0]), kn2 = __builtin_bit_cast(float, nt[NH]);
        const float skipB = 38.0f + 2.0f * sqrtf(qn2) * sqrtf(kn2) * 1.001f;
        attn_unit(bh >> 4, bh & 15, q0, nrows, Qg, Kg, Vg, SGA, MRG, FB + (size_t)bh * TT, skipB, dostore, shm);
    }
}
}


#define XB_TMO      128
#define XB_XCNT(j)  (256  + 64 * (j))
#define XB_XSUB(j)  (1280 + 64 * (j))
#define XB_XGEN(j)  (2304 + 64 * (j))
#define XB_TOP      3328
#define XB_TOPGEN   3392
#define XCD_BAR_WORDS 3456
#define XB_SPIN_CAP (1u << 22)
constexpr int CW_BAR = 1024;
constexpr size_t CTL_ZERO_BYTES = (size_t)(CW_BAR + XCD_BAR_WORDS) * 4;
constexpr int LDS_XB = 139264 + 256;
__device__ __forceinline__ unsigned xb_ld(unsigned* p)              { return __hip_atomic_load(p, __ATOMIC_RELAXED, __HIP_MEMORY_SCOPE_AGENT); }
__device__ __forceinline__ unsigned xb_add(unsigned* p, unsigned v) { return __hip_atomic_fetch_add(p, v, __ATOMIC_RELAXED, __HIP_MEMORY_SCOPE_AGENT); }
__device__ __forceinline__ unsigned xb_xcc_id() { return (unsigned)__builtin_amdgcn_s_getreg((3 << 11) | 20) & 0xFu; }
#define XB_SPIN(cond, bar) do { unsigned _sp = 0; while (cond) { __builtin_amdgcn_s_sleep(1); \
    if ((++_sp & 255u) == 0u) { if (xb_ld(&(bar)[XB_TMO])) break; if (_sp > XB_SPIN_CAP) { atomicAdd(&(bar)[XB_TMO], 1u); break; } } } } while (0)
struct XcdBarrier { unsigned* bar; unsigned x; volatile LAS unsigned* st; };
__device__ __forceinline__ XcdBarrier xcd_barrier_post(unsigned* bar, volatile LAS unsigned* st) {
    XcdBarrier b; b.bar = bar; b.x = xb_xcc_id(); b.st = st;
    if (threadIdx.x == 0) (void)xb_add(&bar[XB_XCNT(b.x)], 1u);
    return b;
}
__device__ __forceinline__ void xcd_barrier_complete(unsigned* bar, unsigned x, unsigned& nloc, unsigned& nx) {
    const unsigned G = gridDim.x * gridDim.y * gridDim.z;
    unsigned sum, cnt, mine, sp = 0u;
    for (;;) {
        sum = 0u; cnt = 0u; mine = 0u;
#pragma unroll
        for (unsigned j = 0; j < 16; ++j) { const unsigned c = xb_ld(&bar[XB_XCNT(j)]); sum += c; cnt += (c > 0u) ? 1u : 0u; mine = (j == x) ? c : mine; }
        if (sum == G) break;
        __builtin_amdgcn_s_sleep(1);
        if ((++sp & 255u) == 0u) { if (xb_ld(&bar[XB_TMO])) break; if (sp > XB_SPIN_CAP) { atomicAdd(&bar[XB_TMO], 1u); break; } }
    }
    nloc = mine > 0u ? mine : 1u; nx = cnt > 0u ? cnt : 1u;
}
__device__ __forceinline__ void xcd_barrier(unsigned* bar, volatile LAS unsigned* st) {
    asm volatile("s_waitcnt vmcnt(0)" ::: "memory");
    __syncthreads();
    if (threadIdx.x == 0) {
        const unsigned x = xb_xcc_id();
        __builtin_amdgcn_s_waitcnt(0);
        unsigned nloc = st[0], nx = st[1];
        if (nloc == 0u) { xcd_barrier_complete(bar, x, nloc, nx); st[0] = nloc; st[1] = nx; }
        const unsigned old = xb_add(&bar[XB_XSUB(x)], 1u);
        const unsigned gen = old / nloc;
        if (old + 1u == (gen + 1u) * nloc) {
            __builtin_amdgcn_fence(__ATOMIC_RELEASE, "agent");
            asm volatile("s_waitcnt vmcnt(0)" ::: "memory");
            const unsigned og = xb_add(&bar[XB_TOP], 1u);
            const unsigned tg = og / nx;
            if (og + 1u == (tg + 1u) * nx) xb_add(&bar[XB_TOPGEN], 1u);
            else XB_SPIN(xb_ld(&bar[XB_TOPGEN]) == tg, bar);
            __builtin_amdgcn_fence(__ATOMIC_ACQUIRE, "agent");
            xb_add(&bar[XB_XGEN(x)], 1u);
            asm volatile("s_waitcnt vmcnt(0)" ::: "memory");
        } else {
            XB_SPIN(xb_ld(&bar[XB_XGEN(x)]) == gen, bar);
            __builtin_amdgcn_fence(__ATOMIC_ACQUIRE, "agent");
            asm volatile("s_waitcnt vmcnt(0)" ::: "memory");
        }
    }
    __syncthreads();
}

__global__ void __launch_bounds__(512, 2) mega_fwd(Params p_unused) {
    extern __shared__ __attribute__((aligned(16))) unsigned char lds_raw[];
    LAS unsigned char* lds = (LAS unsigned char*)lds_raw;
    cg::grid_group grid = cg::this_grid();
    { unsigned* ctl0 = (unsigned*)(params_opaque()->ws + WS_CTL);
      if (threadIdx.x == 0) { ((volatile LAS unsigned*)(lds + LDS_XB))[0] = 0u; ((volatile LAS unsigned*)(lds + LDS_XB))[1] = 0u; }
      if (blockIdx.x == 0) { unsigned zz = 0u; asm volatile("" : "+v"(zz));
          for (int i = (int)threadIdx.x; i < (int)(CTL_ZERO_BYTES / 4); i += 512) ctl0[i] = zz; } }
    __syncthreads();

    { KP p = params_opaque();
      for (int ci = blockIdx.x; ci < CV_Z + CV_IN8; ci += gridDim.x) conv_wg_item(p, 0, 0, ci, lds);
      norm_pass<0>(p, nullptr);
    }
    grid.sync();
    { unsigned* barw = (unsigned*)(params_opaque()->ws + WS_CTL) + CW_BAR; const unsigned xcc = xb_xcc_id();
      if (threadIdx.x == 0) (void)xb_add(barw + XB_XCNT(xcc), 1u); }

#pragma unroll 1
    for (int l = 0; l < DEPTH; ++l) {
        { KP p = params_opaque(); unsigned char* ws = p->ws;
          pg8::Gemm g{(const bf16_t*)(ws + WS_HB), (const bf16_t*)(ws + WS_WIN), MM, NIN, DM}; pg8::StaticOrder S; S.init(MM, NIN, (int)gridDim.x, (int)blockIdx.x);
          sk::forget_phase((const bf16_t*)(ws + WS_HB), (const bf16_t*)(ws + WS_WIN) + (size_t)NIN * DM, (const float*)(ws + WS_RSTD), p->b_forget + l * NH, (float*)(ws + WS_LOGF));
          { sk::EpiInM EM{(bf16_t*)(ws + WS_Z), (const float*)(ws + WS_RSTD)}; sk::phase<DM>(lds, (const bf16_t*)(ws + WS_HB) + (size_t)MM * DM, (const bf16_t*)(ws + WS_WIN), EM, 0, (int)gridDim.x); }
          pg8::EpiIn E{(bf16_t*)(ws + WS_Z), (const float*)(ws + WS_RSTD)};
          _Pragma("unroll 1") for (int rep = 0; rep < PROBE_GEMM_REPS * PROBE_A_REPS; ++rep) pg8::gemm_phase<pg8::EpiIn, pg8::StaticOrder, true>(lds, g, S, E); }
        GSYNC();
        { KP p = params_opaque();
          _Pragma("unroll 1") for (int rep = 0; rep < PROBE_S_REPS; ++rep) {
          if (blockIdx.x < 64) scan_unit(p, (int)blockIdx.x, lds);
          qknorm_phase(p, l, lds);
          poolgate_phase(p, l); } }
        GSYNC();
        { KP p = params_opaque(); _Pragma("unroll 1") for (int pass = 0; pass < PROBE_ATT_REPS; ++pass) att::attn_phase(p, l, pass, lds); }
        GSYNC();
        { KP p = params_opaque(); unsigned char* ws = p->ws;
          { sk::EpiPlainM EM{(bf16_t*)(ws + WS_MIX)}; sk::phase<DM>(lds, (const bf16_t*)p->out + (size_t)MM * DM, (const bf16_t*)(ws + WS_WOUT), EM, 0, (int)gridDim.x); }
          pg8::Gemm g{(const bf16_t*)p->out, (const bf16_t*)(ws + WS_WOUT), MM, DM, DM}; pg8::StaticOrder S; S.init(MM, DM, (int)gridDim.x, (int)blockIdx.x);
          pg8::EpiPlain E{(bf16_t*)(ws + WS_MIX), DM};
          _Pragma("unroll 1") for (int rep = 0; rep < PROBE_GEMM_REPS * PROBE_C_REPS; ++rep) pg8::gemm_phase<pg8::EpiPlain, pg8::StaticOrder, true>(lds, g, S, E); }
        GSYNC();
        { KP p = params_opaque(); _Pragma("unroll 1") for (int rep = 0; rep < PROBE_NORM_DRY; ++rep) norm_pass<1, true>(p, p->n_mix_post + l * DM);
          norm_pass<1>(p, p->n_mix_post + l * DM); }
        GSYNC();
        { KP p = params_opaque(); unsigned char* ws = p->ws;
          { sk::EpiSwigluM EM{(bf16_t*)(ws + WS_FF), (const float*)(ws + WS_RSTD)}; sk::phase<DM>(lds, (const bf16_t*)(ws + WS_HB) + (size_t)MM * DM, (const bf16_t*)(ws + WS_WGU), EM, 0, (int)gridDim.x); }
          pg8::Gemm g{(const bf16_t*)(ws + WS_HB), (const bf16_t*)(ws + WS_WGU), MM, NGU, DM}; pg8::StaticOrder S; S.init(MM, NGU, (int)gridDim.x, (int)blockIdx.x);
          pg8::EpiSwiglu E{(bf16_t*)(ws + WS_FF), (const float*)(ws + WS_RSTD)};
          _Pragma("unroll 1") for (int rep = 0; rep < PROBE_GEMM_REPS * PROBE_D_REPS; ++rep) pg8::gemm_phase<pg8::EpiSwiglu, pg8::StaticOrder, true>(lds, g, S, E); }
        GSYNC();
        { KP p = params_opaque(); unsigned char* ws = p->ws;
          { sk::EpiPlainM EM{(bf16_t*)(ws + WS_MIX)}; sk::phase<DFF>(lds, (const bf16_t*)(ws + WS_FF) + (size_t)MM * DFF, (const bf16_t*)(ws + WS_WDN), EM, 0, (int)gridDim.x); }
          pg8::Gemm g{(const bf16_t*)(ws + WS_FF), (const bf16_t*)(ws + WS_WDN), MM, DM, DFF}; pg8::StaticOrder S; S.init(MM, DM, (int)gridDim.x, (int)blockIdx.x);
          pg8::EpiPlain E{(bf16_t*)(ws + WS_MIX), DM};
          _Pragma("unroll 1") for (int rep = 0; rep < PROBE_GEMM_REPS * PROBE_E_REPS; ++rep) pg8::gemm_phase<pg8::EpiPlain, pg8::StaticOrder, true>(lds, g, S, E); }
        GSYNC();
        { KP p = params_opaque();
          if (l + 1 < DEPTH) norm_pass<1>(p, p->n_ffn_post + l * DM); else norm_pass<2>(p, p->n_ffn_post + l * DM); }
        if (l + 1 < DEPTH) GSYNC();
    }
}

extern "C" void kernel_launch(void* const* d_in, const int* in_sizes, int n_in, void* d_out, int out_size, void* d_ws, size_t ws_size, hipStream_t stream) {
    static int grid_blocks = 0;
    if (grid_blocks == 0) {
        if (n_in != 14 || ws_size < WS_END) { fprintf(stderr, "kernel_launch: unexpected n_in %d or ws_size %zu (< %zu)\n", n_in, ws_size, (size_t)WS_END); grid_blocks = -1; return; }
        int dev = 0, cus = 0, per_cu = 0;
        hipGetDevice(&dev);
        hipDeviceGetAttribute(&cus, hipDeviceAttributeMultiprocessorCount, dev);
        if (hipFuncSetAttribute((const void*)mega_fwd, hipFuncAttributeMaxDynamicSharedMemorySize, LDS_BYTES) != hipSuccess) { fprintf(stderr, "kernel_launch: hipFuncSetAttribute failed\n"); grid_blocks = -1; return; }
        hipOccupancyMaxActiveBlocksPerMultiprocessor(&per_cu, (const void*)mega_fwd, 512, LDS_BYTES);
        if (per_cu < 1) per_cu = 1;
        grid_blocks = cus * per_cu;
        (void)hipGetLastError();
    }
    if (grid_blocks < 0) return;
    Params p{};
    p.x = (const float*)d_in[0]; p.meta = (const float*)d_in[1]; p.n_mix_pre = (const float*)d_in[2]; p.n_mix_post = (const float*)d_in[3];
    p.n_ffn_pre = (const float*)d_in[4]; p.n_ffn_post = (const float*)d_in[5]; p.w_in = (const float*)d_in[6]; p.b_forget = (const float*)d_in[7];
    p.w_pool = (const float*)d_in[8]; p.pool_scale = (const float*)d_in[9]; p.w_out = (const float*)d_in[10]; p.w_gate = (const float*)d_in[11];
    p.w_up = (const float*)d_in[12]; p.w_down = (const float*)d_in[13];
    p.out = (float*)d_out; p.ws = (unsigned char*)d_ws;
    void* args[] = {&p};
    hipError_t e = hipLaunchCooperativeKernel((const void*)mega_fwd, dim3(grid_blocks), dim3(512), args, LDS_BYTES, stream);
    if (e != hipSuccess) fprintf(stderr, "cooperative launch failed: %s (grid %d)\n", hipGetErrorString(e), grid_blocks);
}
```

```cpp
#include <hip/hip_runtime.h>
#include <hip/hip_cooperative_groups.h>
#include <cstdio>
#include <cstdint>
namespace cg = cooperative_groups;

#define LAS __attribute__((address_space(3)))
__device__ __forceinline__ int tid_opaque() { int t = threadIdx.x; asm volatile("" : "+v"(t)); return t; }
typedef unsigned short bf16_t;
typedef short bf16x8 __attribute__((ext_vector_type(8)));
typedef short s16x4 __attribute__((ext_vector_type(4)));
typedef float f32x4 __attribute__((ext_vector_type(4)));
typedef float f32x2 __attribute__((ext_vector_type(2)));
typedef float f32x16 __attribute__((ext_vector_type(16)));
typedef unsigned u32x4 __attribute__((ext_vector_type(4)));
typedef unsigned u32x2 __attribute__((ext_vector_type(2)));
typedef __bf16 bf16x2_t __attribute__((ext_vector_type(2)));

constexpr int NB = 4, SEQ = 8192, META = 16, TT = SEQ + META, DM = 1024, NH = 16, HD = 64, DFF = 2816, DEPTH = 4;
constexpr int MREAL = NB * TT;
constexpr int MP = 33024;
constexpr int MM = NB * SEQ;
constexpr int NIN_SRC = 6160;
constexpr int NIN = 6400;
constexpr int NGU = 2 * DFF;
constexpr float RMS_EPS = 1e-6f;
constexpr float LOG2E = 1.4426950408889634f;
constexpr float C2 = 0.125f * LOG2E;
constexpr float NEGBIG = -1e30f;
__device__ __forceinline__ int compact_row(int b, int t) { return t < META ? MM + b * META + t : b * SEQ + (t - META); }

constexpr size_t MiB = 1u << 20;
constexpr size_t WS_CTL = 0;
constexpr size_t WS_LOGF = 1 * MiB;
constexpr size_t WS_FB = 4 * MiB;
constexpr size_t WS_RSTD = 7 * MiB;
constexpr size_t WS_WIN = 8 * MiB;
constexpr size_t WS_WOUT = 21 * MiB;
constexpr size_t WS_WGU = 23 * MiB;
constexpr size_t WS_WDN = 34 * MiB;
constexpr size_t SLOT = 65 * MiB;
constexpr size_t WS_HB = 40 * MiB;
constexpr size_t WS_Z = WS_HB + SLOT;
constexpr size_t WS_V = WS_Z + 3 * SLOT;
constexpr size_t WS_MIX = WS_V;
constexpr size_t WS_FF = WS_Z;
constexpr size_t WS_END = WS_Z + 6 * SLOT;
static_assert((size_t)MP * DM * 2 <= SLOT, "slot");
static_assert((size_t)MP * DFF * 2 <= 3 * SLOT, "ff overlay");
static_assert((size_t)NIN * DM * 2 <= 13 * MiB && (size_t)NGU * DM * 2 <= 11 * MiB && (size_t)DM * DFF * 2 <= 6 * MiB, "weights");

#ifndef PROBE_A_REPS
#define PROBE_A_REPS 1
#endif
#ifndef PROBE_C_REPS
#define PROBE_C_REPS 1
#endif
#ifndef PROBE_D_REPS
#define PROBE_D_REPS 1
#endif
#ifndef PROBE_E_REPS
#define PROBE_E_REPS 1
#endif
#ifndef PROBE_GEMM_REPS
#define PROBE_GEMM_REPS 1
#endif
#ifndef PROBE_ATT_REPS
#define PROBE_ATT_REPS 1
#endif
#ifndef PROBE_S_REPS
#define PROBE_S_REPS 1
#endif
#ifndef PROBE_CONV_REPS
#define PROBE_CONV_REPS 1
#endif
#ifndef PROBE_NORM_DRY
#define PROBE_NORM_DRY 0
#endif
#ifndef PROBE_SYNC_REPS
#define PROBE_SYNC_REPS 1
#endif
#define GSYNC() do { _Pragma("unroll 1") for (int rep_ = 0; rep_ < PROBE_SYNC_REPS; ++rep_) xcd_barrier((unsigned*)(params_opaque()->ws + WS_CTL) + CW_BAR, (volatile LAS unsigned*)(lds + LDS_XB)); } while (0)
constexpr int LDS_BYTES = 147456;
constexpr int LDS_BF = 139264;

namespace pg8 {
constexpr int BM = 256, BK = 64, HALF = 128, HTB = HALF * BK * 2, STAGE_BYTES = 8 * HTB, NXCD = 8, WGM = 4;
__host__ __device__ __forceinline__ int lds_byte(int r, int c) { const int st = (r >> 4) * 2 + (c >> 5), rr = r & 15, cc = c & 31, ob = rr * 64 + cc * 2; return st * 1024 + (ob ^ (((ob >> 9) & 1) << 5)); }
__host__ __device__ __forceinline__ void stage_rc(int b, int& R, int& C) { const int st = b / 1024, sb = b % 1024, swz = sb ^ (((sb >> 9) & 1) << 5); R = (st >> 1) * 16 + swz / 64; C = (st & 1) * 32 + (swz % 64) / 2; }
__host__ __device__ __forceinline__ int perm32(int rho) { const int n = rho >> 4, i = rho & 15; return 8 * (i >> 2) + 4 * n + (i & 3); }
struct Unit { int pm, pn; };
struct Gemm { const bf16_t* A; const bf16_t* Bt; int M, N, K; };
struct StaticOrder {
    int nM, nN, nwg, G, c;
    __device__ void init(int M, int N, int G_, int c_) { nM = M / BM; nN = N / BM; nwg = nM * nN; G = G_; c = c_; }
    __device__ bool next(int i, Unit& u) const {
        const long L = (long)i * G + c; if (L >= nwg) return false;
        int wgid = (int)L; { const int q = nwg / NXCD, r = nwg % NXCD, xcd = wgid % NXCD, off = wgid / NXCD; wgid = (xcd < r ? xcd * (q + 1) : r * (q + 1) + (xcd - r) * q) + off; }
        const int nig = WGM * nN, gid = wgid / nig, fm = gid * WGM, gsz = (nM - fm) < WGM ? (nM - fm) : WGM;
        u.pm = fm + ((wgid % nig) % gsz); u.pn = (wgid % nig) / gsz; return true;
    }
    __device__ __forceinline__ void a_ready(const Unit&) const {}
    __device__ __forceinline__ void done(const Unit&) const {}
};
__device__ __forceinline__ unsigned cvt_pk_bf16(float lo, float hi) { typedef float f2_ __attribute__((ext_vector_type(2))); typedef __bf16 b2_ __attribute__((ext_vector_type(2))); f2_ v = {lo, hi}; b2_ b = __builtin_convertvector(v, b2_); return __builtin_bit_cast(unsigned, b); }
__device__ __forceinline__ float sigmoidf_(float x) { return __builtin_amdgcn_rcpf(1.0f + __builtin_amdgcn_exp2f(-x * LOG2E)); }

struct EpiPlain {
    static constexpr bool PERM = true, AFTER_DRAIN = false;
    bf16_t* O; int ldc;
    __device__ __forceinline__ void operator()(const f32x4 (&acc)[2][2][4][2], const Unit& u, int wr, int wc, int fr, int fq) const {
        const int row0 = u.pm * BM + wr * 64 + fr; const int col0 = u.pn * BM + wc * 32 + 8 * fq;
#pragma unroll
        for (int ai = 0; ai < 2; ++ai)
#pragma unroll
            for (int m = 0; m < 4; ++m) { bf16_t* rowp = O + (size_t)(row0 + ai * HALF + m * 16) * ldc + col0;
#pragma unroll
                for (int bj = 0; bj < 2; ++bj) { const f32x4 v0 = acc[ai][bj][m][0], v1 = acc[ai][bj][m][1];
                    u32x4 w; w.x = cvt_pk_bf16(v0[0], v0[1]); w.y = cvt_pk_bf16(v0[2], v0[3]); w.z = cvt_pk_bf16(v1[0], v1[1]); w.w = cvt_pk_bf16(v1[2], v1[3]);
                    *(u32x4*)(rowp + bj * HALF) = w; } }
    }
};
struct EpiIn {
    static constexpr bool PERM = true, AFTER_DRAIN = false;
    bf16_t* Z; LAS const float* bfor; const float* rstd;
    __device__ __forceinline__ void operator()(const f32x4 (&acc)[2][2][4][2], const Unit& u, int wr, int wc, int fr, int fq) const {
        const int row0 = u.pm * BM + wr * 64 + fr + META * ((u.pm >> 5) + 1);
        if (u.pn < 24) {
            const int kind = u.pn >> 2; bf16_t* base = Z + (size_t)kind * (SLOT / 2); const int col0 = (u.pn & 3) * BM + wc * 32 + 8 * fq;
#pragma unroll
            for (int ai = 0; ai < 2; ++ai)
#pragma unroll
                for (int m = 0; m < 4; ++m) { bf16_t* rowp = base + (size_t)(row0 + ai * HALF + m * 16) * DM + col0;
                    const float rs = rstd[u.pm * BM + wr * 64 + fr + ai * HALF + m * 16];
#pragma unroll
                    for (int bj = 0; bj < 2; ++bj) { f32x4 v0 = acc[ai][bj][m][0] * rs, v1 = acc[ai][bj][m][1] * rs;
                        if (kind == 1) { v0 = v0 * C2; v1 = v1 * C2; }
                        else if (kind >= 4) {
#pragma unroll
                            for (int i = 0; i < 4; ++i) { v0[i] = sigmoidf_(v0[i]); v1[i] = sigmoidf_(v1[i]); } }
                        u32x4 w; w.x = cvt_pk_bf16(v0[0], v0[1]); w.y = cvt_pk_bf16(v0[2], v0[3]); w.z = cvt_pk_bf16(v1[0], v1[1]); w.w = cvt_pk_bf16(v1[2], v1[3]);
                        *(u32x4*)(rowp + bj * HALF) = w; } }
        } else if (wc == 0 && fq < 2) {
#pragma unroll
            for (int n = 0; n < 2; ++n)
#pragma unroll
                for (int i = 0; i < 4; ++i) { const int col = 8 * fq + 4 * n + i; const float bb = bfor[col];
#pragma unroll
                    for (int ai = 0; ai < 2; ++ai)
#pragma unroll
                        for (int m = 0; m < 4; ++m) { const int row = row0 + ai * HALF + m * 16; const float x = acc[ai][0][m][n][i] * rstd[u.pm * BM + wr * 64 + fr + ai * HALF + m * 16] + bb;
                            const float ls = fminf(x, 0.f) - __logf(1.0f + __expf(-fabsf(x)));
                            ((float*)((unsigned char*)Z - (WS_Z - WS_LOGF)))[(size_t)col * MP + row] = ls; } }
        }
    }
};
struct EpiSwiglu {
    static constexpr bool PERM = true, AFTER_DRAIN = false;
    bf16_t* O; const float* rstd;
    __device__ __forceinline__ void operator()(const f32x4 (&acc)[2][2][4][2], const Unit& u, int wr, int wc, int fr, int fq) const {
        const int row0 = u.pm * BM + wr * 64 + fr; const int col0 = u.pn * HALF + wc * 32 + 8 * fq;
#pragma unroll
        for (int ai = 0; ai < 2; ++ai)
#pragma unroll
            for (int m = 0; m < 4; ++m) { bf16_t* rowp = O + (size_t)(row0 + ai * HALF + m * 16) * DFF + col0;
                f32x4 r0, r1; const float rs = rstd[row0 + ai * HALF + m * 16];
#pragma unroll
                for (int i = 0; i < 4; ++i) { const float g0 = acc[ai][0][m][0][i] * rs, g1 = acc[ai][0][m][1][i] * rs;
                    r0[i] = g0 * sigmoidf_(g0) * (acc[ai][1][m][0][i] * rs); r1[i] = g1 * sigmoidf_(g1) * (acc[ai][1][m][1][i] * rs); }
                u32x4 w; w.x = cvt_pk_bf16(r0[0], r0[1]); w.y = cvt_pk_bf16(r0[2], r0[3]); w.z = cvt_pk_bf16(r1[0], r1[1]); w.w = cvt_pk_bf16(r1[2], r1[3]);
                *(u32x4*)rowp = w; }
    }
};

template <class Epi, class Sched, bool ALIGN_EPI = false>
__device__ __forceinline__ void gemm_phase(LAS unsigned char* lds, const Gemm g, const Sched& S, const Epi& E) {
    const int tid = tid_opaque(), wid = __builtin_amdgcn_readfirstlane(tid >> 6), lane = tid & 63, wr = wid >> 2, wc = wid & 3, fr = lane & 15, fq = lane >> 4;
    const int K = g.K, nt = K / BK;
    unsigned voffA[2], voffB[2];
#pragma unroll
    for (int i = 0; i < 2; ++i) { int R, C; stage_rc(tid * 16 + i * 8192, R, C); const int Rb = Epi::PERM ? ((R & ~31) + perm32(R & 31)) : R;
        voffA[i] = (unsigned)(R * K + C) * 2u; voffB[i] = (unsigned)(Rb * K + C) * 2u; }
    const size_t kstep = (size_t)(BK * 2);
    const size_t hstep = (size_t)HALF * K * 2;
    const size_t tstep = 2 * hstep;
    const unsigned ldsw = (unsigned)wid * 1024u;
    const int aoff = lds_byte(wr * 64 + fr, fq * 8), boff = lds_byte(wc * 32 + fr, fq * 8);
#define PG8_SA(b, h) (((b) * 2 + (h)) * HTB)
#define PG8_SB(b, h) ((4 + (b) * 2 + (h)) * HTB)
#define PG8_STAGE(bufoff, gbase, voff) do { _Pragma("unroll") for (int _i = 0; _i < 2; ++_i) \
        __builtin_amdgcn_global_load_lds((const unsigned*)((const char*)(gbase) + (voff)[_i]), (LAS unsigned*)(lds + (bufoff) + ldsw + _i * 8192), 16, 0, 0); } while (0)
#define PG8_LDA(dst, b, h) do { _Pragma("unroll") for (int m = 0; m < 4; ++m) _Pragma("unroll") for (int k = 0; k < 2; ++k) dst[m][k] = *(const LAS bf16x8*)(lds + PG8_SA(b, h) + aoff + m * 2048 + k * 1024); } while (0)
#define PG8_LDB(dst, b, h) do { _Pragma("unroll") for (int n = 0; n < 2; ++n) _Pragma("unroll") for (int k = 0; k < 2; ++k) dst[n][k] = *(const LAS bf16x8*)(lds + PG8_SB(b, h) + boff + n * 2048 + k * 1024); } while (0)
#define PG8_MMA(ai, bj, At, Bt) do { __builtin_amdgcn_s_setprio(1); _Pragma("unroll") for (int m = 0; m < 4; ++m) _Pragma("unroll") for (int n = 0; n < 2; ++n) _Pragma("unroll") for (int k = 0; k < 2; ++k) \
        acc[ai][bj][m][n] = __builtin_amdgcn_mfma_f32_16x16x32_bf16(Bt[n][k], At[m][k], acc[ai][bj][m][n], 0, 0, 0); __builtin_amdgcn_s_setprio(0); } while (0)
#define PG8_WAIT_V(n) asm volatile("s_waitcnt vmcnt(" #n ")" ::: "memory")
#define PG8_WAIT_L(n) asm volatile("s_waitcnt lgkmcnt(" #n ")" ::: "memory")
#define PG8_BAR __builtin_amdgcn_s_barrier()
#define PG8_SCHED __builtin_amdgcn_sched_barrier(0)
    Unit cur, nxt; int ui = 0;
    if (!S.next(0, cur)) return;
    f32x4 acc[2][2][4][2];
    float zf = 0.f; asm volatile("" : "+v"(zf));
#pragma unroll
    for (int a = 0; a < 2; ++a)
#pragma unroll
        for (int b = 0; b < 2; ++b)
#pragma unroll
            for (int m = 0; m < 4; ++m)
#pragma unroll
                for (int n = 0; n < 2; ++n) acc[a][b][m][n] = (f32x4){zf, zf, zf, zf};
    bf16x8 At[4][2], B0[2][2], B1[2][2];
    const char* cA = (const char*)g.A + (size_t)cur.pm * tstep; const char* cB = (const char*)g.Bt + (size_t)cur.pn * tstep;
    S.a_ready(cur);
    PG8_STAGE(PG8_SB(0, 0), cB, voffB); PG8_STAGE(PG8_SB(0, 1), cB + hstep, voffB); PG8_STAGE(PG8_SA(0, 0), cA, voffA); PG8_STAGE(PG8_SA(0, 1), cA + hstep, voffA);
    if (wr == 1) PG8_BAR;
    PG8_WAIT_V(2); PG8_BAR;
    PG8_STAGE(PG8_SB(1, 0), cB + kstep, voffB); PG8_STAGE(PG8_SA(1, 0), cA + kstep, voffA); PG8_STAGE(PG8_SB(1, 1), cB + hstep + kstep, voffB);
    PG8_WAIT_V(6); PG8_BAR;
    for (;;) {
        const bool has_next = S.next(ui + 1, nxt);
        const char* nA = has_next ? (const char*)g.A + (size_t)nxt.pm * tstep : cA; const char* nB = has_next ? (const char*)g.Bt + (size_t)nxt.pn * tstep : cB;
        for (int t = 0; t < nt; t += 2) {
            const bool last = (t == nt - 2);
            const char* a1 = cA + (size_t)(t + 1) * kstep;
            const char* a2 = last ? nA : cA + (size_t)(t + 2) * kstep; const char* b2 = last ? nB : cB + (size_t)(t + 2) * kstep;
            const char* a3 = a2 + kstep; const char* b3 = b2 + kstep;
            if (last && has_next) S.a_ready(nxt);
            PG8_LDB(B0, 0, 0); PG8_LDB(B1, 0, 1); PG8_SCHED; PG8_LDA(At, 0, 0); PG8_STAGE(PG8_SA(1, 1), a1 + hstep, voffA);
            PG8_WAIT_V(8); PG8_WAIT_L(0); PG8_BAR; PG8_MMA(0, 0, At, B0); PG8_MMA(0, 1, At, B1); PG8_BAR; PG8_SCHED;
            PG8_LDA(At, 0, 1); PG8_STAGE(PG8_SB(0, 0), b2, voffB); PG8_STAGE(PG8_SB(0, 1), b2 + hstep, voffB); PG8_STAGE(PG8_SA(0, 0), a2, voffA);
            PG8_WAIT_V(8); PG8_WAIT_L(0); PG8_BAR; PG8_MMA(1, 0, At, B0); PG8_MMA(1, 1, At, B1); PG8_BAR; PG8_SCHED;
            PG8_LDB(B0, 1, 0); PG8_LDB(B1, 1, 1); PG8_SCHED; PG8_LDA(At, 1, 0); PG8_STAGE(PG8_SA(0, 1), a2 + hstep, voffA);
            PG8_WAIT_V(8); PG8_WAIT_L(0); PG8_BAR; PG8_MMA(0, 0, At, B0); PG8_MMA(0, 1, At, B1); PG8_BAR; PG8_SCHED;
            PG8_LDA(At, 1, 1); PG8_STAGE(PG8_SB(1, 0), b3, voffB); PG8_STAGE(PG8_SB(1, 1), b3 + hstep, voffB); PG8_STAGE(PG8_SA(1, 0), a3, voffA);
            PG8_WAIT_V(8); PG8_WAIT_L(0); PG8_BAR; PG8_MMA(1, 0, At, B0); PG8_MMA(1, 1, At, B1); PG8_BAR; PG8_SCHED;
        }
        if constexpr (ALIGN_EPI) { if (wr == 0) PG8_BAR; }
        E(acc, cur, wr, wc, fr, fq); S.done(cur);
        if (!has_next) break;
#pragma unroll
        for (int a = 0; a < 2; ++a)
#pragma unroll
            for (int b = 0; b < 2; ++b)
#pragma unroll
                for (int m = 0; m < 4; ++m)
#pragma unroll
                    for (int n = 0; n < 2; ++n) acc[a][b][m][n] = (f32x4){zf, zf, zf, zf};
        cur = nxt; cA = nA; cB = nB; ++ui;
        if constexpr (ALIGN_EPI) { if (wr == 1) PG8_BAR; }
    }
    PG8_WAIT_V(0);
    if constexpr (!ALIGN_EPI) { if (wr == 0) PG8_BAR; }
    PG8_BAR;
#undef PG8_SA
#undef PG8_SB
#undef PG8_STAGE
#undef PG8_LDA
#undef PG8_LDB
#undef PG8_MMA
#undef PG8_WAIT_V
#undef PG8_WAIT_L
#undef PG8_BAR
#undef PG8_SCHED
}
}

__device__ __forceinline__ unsigned f2bf(float f) { unsigned u = __builtin_bit_cast(unsigned, f); return (u + 0x7fffu + ((u >> 16) & 1u)) >> 16; }
__device__ __forceinline__ unsigned pk2(float lo, float hi) { f32x2 v = {lo, hi}; bf16x2_t b = __builtin_convertvector(v, bf16x2_t); return __builtin_bit_cast(unsigned, b); }
__device__ __forceinline__ float bf_lo(unsigned w) { return __builtin_bit_cast(float, w << 16); }
__device__ __forceinline__ float bf_hi(unsigned w) { return __builtin_bit_cast(float, w & 0xffff0000u); }
__device__ __forceinline__ float wave_sum(float v) {
#pragma unroll
    for (int o = 1; o < 64; o <<= 1) v += __shfl_xor(v, o);
    return v;
}
__device__ __forceinline__ unsigned cvtpk_s(float lo, float hi) { f32x2 v = {lo, hi}; bf16x2_t b = __builtin_convertvector(v, bf16x2_t); return __builtin_bit_cast(unsigned, b); }

struct Params {
    const float* x; const float* meta; const float* n_mix_pre; const float* n_mix_post; const float* n_ffn_pre; const float* n_ffn_post;
    const float* w_in; const float* b_forget; const float* w_pool; const float* pool_scale; const float* w_out; const float* w_gate; const float* w_up; const float* w_down;
    float* out; unsigned char* ws;
};
typedef const __attribute__((address_space(4))) Params* KP;
__device__ __forceinline__ KP params_opaque() { KP q = (KP)__builtin_amdgcn_kernarg_segment_ptr(); asm volatile("" : "+s"(q)); return q; }


namespace sk {
struct EpiInM {
    bf16_t* Z; LAS const float* bfor; const float* rstd;
    static constexpr int NBB = 1;
    __device__ __forceinline__ int nunits() const { return 6144 / 16 + 1; }
    __device__ __forceinline__ int brow(int u, int nb) const { return 16 * u; }
    __device__ __forceinline__ void operator()(const f32x4 (&a)[1], int u, int rb, int fr, int fq) const {
        const int n0 = 16 * u; const size_t nrow = (size_t)rb * TT + fr;
        const float rs = rstd[MM + 16 * rb + fr];
        if (n0 < 6144) { const int kind = n0 >> 10; f32x4 v = a[0] * rs;
            if (kind == 1) v = v * C2; else if (kind >= 4) { v[0] = pg8::sigmoidf_(v[0]); v[1] = pg8::sigmoidf_(v[1]); v[2] = pg8::sigmoidf_(v[2]); v[3] = pg8::sigmoidf_(v[3]); }
            *(u32x2*)(Z + (size_t)kind * (SLOT / 2) + nrow * DM + (n0 & 1023) + 4 * fq) = (u32x2){pg8::cvt_pk_bf16(v[0], v[1]), pg8::cvt_pk_bf16(v[2], v[3])};
        } else {
#pragma unroll
            for (int i = 0; i < 4; ++i) { const int col = 4 * fq + i; const float x = a[0][i] * rs + bfor[col]; const float ls = fminf(x, 0.f) - __logf(1.0f + __expf(-fabsf(x)));
                ((float*)((unsigned char*)Z - (WS_Z - WS_LOGF)))[(size_t)col * MP + nrow] = ls; }
        }
    }
};
struct EpiPlainM {
    bf16_t* O;
    static constexpr int NBB = 1;
    __device__ __forceinline__ int nunits() const { return DM / 16; }
    __device__ __forceinline__ int brow(int u, int nb) const { return 16 * u; }
    __device__ __forceinline__ void operator()(const f32x4 (&a)[1], int u, int rb, int fr, int fq) const {
        *(u32x2*)(O + (size_t)(MM + 16 * rb + fr) * DM + 16 * u + 4 * fq) = (u32x2){pg8::cvt_pk_bf16(a[0][0], a[0][1]), pg8::cvt_pk_bf16(a[0][2], a[0][3])};
    }
};
struct EpiSwigluM {
    bf16_t* O; const float* rstd;
    static constexpr int NBB = 2;
    __device__ __forceinline__ int nunits() const { return DFF / 16; }
    __device__ __forceinline__ int brow(int u, int nb) const { const int ch = 16 * u; return (ch >> 7) * 256 + nb * 128 + (ch & 127); }
    __device__ __forceinline__ void operator()(const f32x4 (&a)[2], int u, int rb, int fr, int fq) const {
        f32x4 r;
        const float rs = rstd[MM + 16 * rb + fr];
#pragma unroll
        for (int i = 0; i < 4; ++i) { const float g = a[0][i] * rs; r[i] = g * pg8::sigmoidf_(g) * (a[1][i] * rs); }
        *(u32x2*)(O + (size_t)(MM + 16 * rb + fr) * DFF + 16 * u + 4 * fq) = (u32x2){pg8::cvt_pk_bf16(r[0], r[1]), pg8::cvt_pk_bf16(r[2], r[3])};
    }
};
template <int K, class Epi>
__device__ __forceinline__ void phase(LAS unsigned char* lds, const bf16_t* A, const bf16_t* Bt, const Epi& E, int ubase, int ustride) {
    if ((int)blockIdx.x < ubase) return;
    constexpr int NBB = Epi::NBB;
    const int tid = tid_opaque(), lane = tid & 63, fr = lane & 15, fq = lane >> 4; const int wave = __builtin_amdgcn_readfirstlane(tid >> 6);
    constexpr int ksteps = K / 256;
    LAS f32x4* red = (LAS f32x4*)lds;
    const int nu = E.nunits();
    for (int u = (int)blockIdx.x - ubase; u < nu; u += ustride) {
        f32x4 acc[NBB][4];
#pragma unroll
        for (int nb = 0; nb < NBB; ++nb)
#pragma unroll
            for (int rb = 0; rb < 4; ++rb) acc[nb][rb] = (f32x4){0.f, 0.f, 0.f, 0.f};
        const bf16_t* ap = A + (size_t)fr * K + wave * ksteps * 32 + 8 * fq;
        const bf16_t* bp0 = Bt + (size_t)(E.brow(u, 0) + fr) * K + wave * ksteps * 32 + 8 * fq;
        const bf16_t* bp1 = Bt + (size_t)(E.brow(u, NBB - 1) + fr) * K + wave * ksteps * 32 + 8 * fq;
#pragma unroll
        for (int st = 0; st < ksteps; ++st) {
            const bf16x8 b0 = *(const bf16x8*)(bp0 + 32 * st); bf16x8 b1; if (NBB == 2) b1 = *(const bf16x8*)(bp1 + 32 * st);
#pragma unroll
            for (int rb = 0; rb < 4; ++rb) { const bf16x8 a = *(const bf16x8*)(ap + (size_t)(16 * rb) * K + 32 * st);
                acc[0][rb] = __builtin_amdgcn_mfma_f32_16x16x32_bf16(b0, a, acc[0][rb], 0, 0, 0);
                if (NBB == 2) acc[NBB - 1][rb] = __builtin_amdgcn_mfma_f32_16x16x32_bf16(b1, a, acc[NBB - 1][rb], 0, 0, 0); }
        }
        __syncthreads();
#pragma unroll
        for (int nb = 0; nb < NBB; ++nb)
#pragma unroll
            for (int rb = 0; rb < 4; ++rb) red[(wave * (NBB * 4) + nb * 4 + rb) * 64 + lane] = acc[nb][rb];
        __syncthreads();
        if (wave < 4) { f32x4 sum[NBB];
#pragma unroll
            for (int nb = 0; nb < NBB; ++nb) { sum[nb] = red[(nb * 4 + wave) * 64 + lane];
#pragma unroll
                for (int w = 1; w < 8; ++w) sum[nb] = sum[nb] + red[(w * (NBB * 4) + nb * 4 + wave) * 64 + lane]; }
            E(sum, u, wave, fr, fq); }
    }
    __syncthreads();
}
}

__device__ __forceinline__ void tr_item(const float* src, int ldw, int nvalid, bf16_t* dst, int ldk, LAS float* scr, int lane, const float* gk = nullptr) {
    { const int kr = lane >> 3, n4 = 4 * (lane & 7);
      f32x4 v[8];
#pragma unroll
      for (int i = 0; i < 8; ++i) { const int kk = 8 * i + kr; v[i] = (n4 < nvalid) ? *(const f32x4*)(src + (size_t)kk * ldw + n4) : (f32x4){0.f, 0.f, 0.f, 0.f}; }
#pragma unroll
      for (int i = 0; i < 8; ++i) { const int kk = 8 * i + kr; const float gsc = gk ? gk[kk] : 1.0f; LAS float* d = scr + kk * 33 + n4;
          d[0] = v[i].x * gsc; d[1] = v[i].y * gsc; d[2] = v[i].z * gsc; d[3] = v[i].w * gsc; } }
    asm volatile("s_waitcnt lgkmcnt(0)" ::: "memory");
    const int c = lane & 7;
#pragma unroll
    for (int j = 0; j < 4; ++j) { const int n = (lane >> 3) + 8 * j; const LAS float* s = scr + (8 * c) * 33 + n;
        u32x4 o; o.x = pk2(s[0 * 33], s[1 * 33]); o.y = pk2(s[2 * 33], s[3 * 33]); o.z = pk2(s[4 * 33], s[5 * 33]); o.w = pk2(s[6 * 33], s[7 * 33]);
        *(u32x4*)(dst + (size_t)n * ldk + 8 * c) = o; }
    asm volatile("s_waitcnt lgkmcnt(0)" ::: "memory");
}

constexpr int CV_SEG = 16 * 32, CV_F = 16, CV_FF = 16 * 88, CV_DN = 44 * 32;
constexpr int CV_Z = 256, CV_IN8 = (5 * CV_SEG + CV_F) / 8, CV_REST8 = (CV_SEG + 2 * CV_FF + CV_DN) / 8;
static_assert(CV_IN8 * 8 == 5 * CV_SEG + CV_F && CV_REST8 * 8 == CV_SEG + 2 * CV_FF + CV_DN, "wave items per workgroup item");
__device__ __forceinline__ void conv_z_item(KP p, int l, int item, LAS unsigned char* lds) {
    const int tid = tid_opaque(), lane = tid & 63, fr = lane & 15, fq = lane >> 4; const int wave = __builtin_amdgcn_readfirstlane(tid >> 6);
    bf16_t* Wt_in = (bf16_t*)(p->ws + WS_WIN); const float* w_in = p->w_in + (size_t)l * DM * NIN_SRC;
    const int g = item >> 6, kb = (item >> 2) & 15, db = item & 3, k0 = kb * 64 + 32 * (wave >> 2), d0 = db * 64 + 16 * (wave & 3);
    const float* wp = p->w_pool + ((size_t)(l * 4 + g) * 256) * 256 + d0 + fr;
    const float* y0 = w_in + (size_t)(k0 + fr) * NIN_SRC + g * 256 + 8 * fq;
    const float* y1 = y0 + (size_t)16 * NIN_SRC;
    const float g0 = p->n_mix_pre[l * DM + k0 + fr], g1 = p->n_mix_pre[l * DM + k0 + 16 + fr];
    f32x4 acc0 = (f32x4){0.f, 0.f, 0.f, 0.f}, acc1 = acc0;
#pragma unroll 4
    for (int st = 0; st < 8; ++st) {
        const int c0 = 32 * st;
        float xf[8];
#pragma unroll
        for (int i = 0; i < 8; ++i) xf[i] = wp[(size_t)(c0 + 8 * fq + i) * 256];
        const f32x4 a0 = *(const f32x4*)(y0 + c0), a1 = *(const f32x4*)(y0 + c0 + 4), b0 = *(const f32x4*)(y1 + c0), b1 = *(const f32x4*)(y1 + c0 + 4);
        const u32x4 xw = (u32x4){cvtpk_s(xf[0], xf[1]), cvtpk_s(xf[2], xf[3]), cvtpk_s(xf[4], xf[5]), cvtpk_s(xf[6], xf[7])};
        const u32x4 yw0 = (u32x4){cvtpk_s(a0.x * g0, a0.y * g0), cvtpk_s(a0.z * g0, a0.w * g0), cvtpk_s(a1.x * g0, a1.y * g0), cvtpk_s(a1.z * g0, a1.w * g0)};
        const u32x4 yw1 = (u32x4){cvtpk_s(b0.x * g1, b0.y * g1), cvtpk_s(b0.z * g1, b0.w * g1), cvtpk_s(b1.x * g1, b1.y * g1), cvtpk_s(b1.z * g1, b1.w * g1)};
        acc0 = __builtin_amdgcn_mfma_f32_16x16x32_bf16(__builtin_bit_cast(bf16x8, xw), __builtin_bit_cast(bf16x8, yw0), acc0, 0, 0, 0);
        acc1 = __builtin_amdgcn_mfma_f32_16x16x32_bf16(__builtin_bit_cast(bf16x8, xw), __builtin_bit_cast(bf16x8, yw1), acc1, 0, 0, 0);
    }
#pragma unroll
    for (int i = 0; i < 4; ++i) { bf16_t* o = Wt_in + (size_t)(g * 256 + d0 + 4 * fq + i) * DM + k0 + fr;
        o[0] = (bf16_t)f2bf(acc0[i]); o[16] = (bf16_t)f2bf(acc1[i]); }
}
__device__ __forceinline__ void conv_tr_in(KP p, int l, int r, LAS float* scr, int lane) {
    bf16_t* Wt_in = (bf16_t*)(p->ws + WS_WIN); const float* w_in = p->w_in + (size_t)l * DM * NIN_SRC;
    if (r < 5 * CV_SEG) { const int seg = r / CV_SEG; r -= seg * CV_SEG; const int kb = r >> 5, nb = r & 31;
        const int srccol = (seg < 3 ? 1024 * (seg + 1) : 4112 + 1024 * (seg - 3)) + 32 * nb;
        tr_item(w_in + (size_t)(64 * kb) * NIN_SRC + srccol, NIN_SRC, 32, Wt_in + (size_t)(1024 * (seg + 1) + 32 * nb) * DM + 64 * kb, DM, scr, lane, p->n_mix_pre + l * DM + 64 * kb);
    } else { r -= 5 * CV_SEG; tr_item(w_in + (size_t)(64 * r) * NIN_SRC + 4096, NIN_SRC, 16, Wt_in + (size_t)6144 * DM + 64 * r, DM, scr, lane, p->n_mix_pre + l * DM + 64 * r); }
}
__device__ __forceinline__ void conv_tr_rest(KP p, int l, int r, LAS float* scr, int lane) {
    bf16_t* Wt_out = (bf16_t*)(p->ws + WS_WOUT); bf16_t* Wt_gu = (bf16_t*)(p->ws + WS_WGU); bf16_t* Wt_dn = (bf16_t*)(p->ws + WS_WDN);
    if (r < CV_SEG) { const int kb = r >> 5, nb = r & 31;
        tr_item(p->w_out + (size_t)l * DM * DM + (size_t)(64 * kb) * DM + 32 * nb, DM, 32, Wt_out + (size_t)(32 * nb) * DM + 64 * kb, DM, scr, lane);
    } else if (r < CV_SEG + 2 * CV_FF) { r -= CV_SEG; const int up = r >= CV_FF; if (up) r -= CV_FF; const int kb = r / 88, nb = r % 88; const int n0 = 32 * nb;
        const float* W = (up ? p->w_up : p->w_gate) + (size_t)l * DM * DFF;
        const int drow = (n0 >> 7) * 256 + (up ? 128 : 0) + (n0 & 127);
        tr_item(W + (size_t)(64 * kb) * DFF + n0, DFF, 32, Wt_gu + (size_t)drow * DM + 64 * kb, DM, scr, lane, p->n_ffn_pre + l * DM + 64 * kb);
    } else { r -= CV_SEG + 2 * CV_FF; const int kb = r >> 5, nb = r & 31;
        tr_item(p->w_down + (size_t)l * DFF * DM + (size_t)(64 * kb) * DM + 32 * nb, DM, 32, Wt_dn + (size_t)(32 * nb) * DFF + 64 * kb, DFF, scr, lane); }
}
__device__ __forceinline__ int conv_count(int l_in, bool rest) { return (l_in < DEPTH ? CV_Z + CV_IN8 : 0) + (rest ? CV_REST8 : 0); }
__device__ __forceinline__ void conv_wg_item(KP p, int l_in, int l_rest, int ci, LAS unsigned char* lds) {
    const int tid = tid_opaque(), lane = tid & 63, wave = tid >> 6;
    LAS float* scr = (LAS float*)(lds + wave * 16384);
    const int nin = (l_in < DEPTH) ? CV_Z + CV_IN8 : 0;
    if (ci < nin) { if (ci < CV_Z) conv_z_item(p, l_in, ci, lds); else conv_tr_in(p, l_in, (ci - CV_Z) * 8 + wave, scr, lane); }
    else conv_tr_rest(p, l_rest, (ci - nin) * 8 + wave, scr, lane);
    __syncthreads();
}

template <int MODE, bool DRY = false>
__device__ __forceinline__ void norm_pass(KP p, const float* g_post) {
    const int tid_ = tid_opaque(); const int lane = tid_ & 63, wave = tid_ >> 6;
    const int gw = blockIdx.x * 8 + wave, NGW = gridDim.x * 8;
    const bf16_t* mix = (const bf16_t*)(p->ws + WS_MIX); bf16_t* X = (bf16_t*)(p->ws + WS_HB); float* rstdA = (float*)(p->ws + WS_RSTD) + (DRY ? 65536 : 0);
    bf16_t* Xw = DRY ? (bf16_t*)(p->ws + WS_Z) : X;
    constexpr int RB = 4;
    f32x4 gpo[4];
#pragma unroll
    for (int j = 0; j < 4; ++j) gpo[j] = (MODE != 0) ? ((const f32x4*)g_post)[lane + 64 * j] : (f32x4){0.f, 0.f, 0.f, 0.f};
    for (int r0 = gw; r0 < MREAL; r0 += RB * NGW) {
        f32x4 v[RB][4]; u32x2 mw[RB][4], xw[RB][4]; bool ok[RB]; int cr[RB], bb[RB], tt[RB];
#pragma unroll
        for (int i = 0; i < RB; ++i) { const int r = r0 + i * NGW; ok[i] = r < MREAL; const int rr = ok[i] ? r : r0; bb[i] = rr / TT; tt[i] = rr - bb[i] * TT; cr[i] = compact_row(bb[i], tt[i]);
            if (MODE == 0) { const float* src = tt[i] < META ? p->meta + (size_t)tt[i] * DM : p->x + ((size_t)bb[i] * SEQ + (tt[i] - META)) * DM;
#pragma unroll
                for (int j = 0; j < 4; ++j) v[i][j] = ((const f32x4*)src)[lane + 64 * j];
            } else { const u32x2* mr = (const u32x2*)(mix + (size_t)cr[i] * DM); const u32x2* xr = (const u32x2*)(X + (size_t)cr[i] * DM);
#pragma unroll
                for (int j = 0; j < 4; ++j) { mw[i][j] = mr[lane + 64 * j]; xw[i][j] = xr[lane + 64 * j]; } } }
        if (MODE != 0) {
            float ss[RB];
#pragma unroll
            for (int i = 0; i < RB; ++i) { ss[i] = 0.f;
#pragma unroll
                for (int j = 0; j < 4; ++j) { const float a = bf_lo(mw[i][j].x), b = bf_hi(mw[i][j].x), c = bf_lo(mw[i][j].y), d = bf_hi(mw[i][j].y); ss[i] += (a * a + b * b) + (c * c + d * d); } }
#pragma unroll
            for (int o = 1; o < 64; o <<= 1) {
#pragma unroll
                for (int i = 0; i < RB; ++i) ss[i] += __shfl_xor(ss[i], o); }
#pragma unroll
            for (int i = 0; i < RB; ++i) { const float rstd = 1.0f / sqrtf(ss[i] * (1.0f / DM) + RMS_EPS);
#pragma unroll
                for (int j = 0; j < 4; ++j) { const f32x4 mx = (f32x4){bf_lo(mw[i][j].x), bf_hi(mw[i][j].x), bf_lo(mw[i][j].y), bf_hi(mw[i][j].y)};
                    const f32x4 xo = (f32x4){bf_lo(xw[i][j].x), bf_hi(xw[i][j].x), bf_lo(xw[i][j].y), bf_hi(xw[i][j].y)}; v[i][j] = xo + mx * rstd * gpo[j]; } }
        }
        if (MODE == 2) {
#pragma unroll
            for (int i = 0; i < RB; ++i) { if (ok[i] && tt[i] >= META) { f32x4* o = (f32x4*)(p->out + ((size_t)bb[i] * SEQ + (tt[i] - META)) * DM);
#pragma unroll
                for (int j = 0; j < 4; ++j) o[lane + 64 * j] = v[i][j]; } }
        } else {
            float s2[RB];
#pragma unroll
            for (int i = 0; i < RB; ++i) { s2[i] = 0.f; u32x2* o = (u32x2*)(Xw + (size_t)cr[i] * DM);
#pragma unroll
                for (int j = 0; j < 4; ++j) { const u32x2 w = (u32x2){pk2(v[i][j].x, v[i][j].y), pk2(v[i][j].z, v[i][j].w)};
                    const float a = bf_lo(w.x), b = bf_hi(w.x), c = bf_lo(w.y), d = bf_hi(w.y); s2[i] += (a * a + b * b) + (c * c + d * d);
                    if (ok[i]) o[lane + 64 * j] = w; } }
#pragma unroll
            for (int o = 1; o < 64; o <<= 1) {
#pragma unroll
                for (int i = 0; i < RB; ++i) s2[i] += __shfl_xor(s2[i], o); }
#pragma unroll
            for (int i = 0; i < RB; ++i) { if (ok[i] && lane == 0) rstdA[cr[i]] = 1.0f / sqrtf(s2[i] * (1.0f / DM) + RMS_EPS); }
        }
    }
}

__device__ __forceinline__ void scan_unit(KP p, int bh, LAS unsigned char* lds) {
    const int tid = tid_opaque(), lane = tid & 63, wave = tid >> 6;
    const int b = bh >> 4, h = bh & 15;
    const float* src = (const float*)(p->ws + WS_LOGF) + (size_t)h * MP + (size_t)b * TT;
    float* dst = (float*)(p->ws + WS_FB) + (size_t)bh * TT;
    LAS float* wt = (LAS float*)lds;
    const int t0 = tid * 17;
    float v[17]; float s = 0.f;
#pragma unroll
    for (int i = 0; i < 17; ++i) { const int t = t0 + i; v[i] = (t < TT) ? src[t] : 0.f; s += v[i]; }
    float inc = s;
#pragma unroll
    for (int o = 1; o < 64; o <<= 1) { const float n = __shfl_up(inc, o); if (lane >= o) inc += n; }
    __syncthreads();
    if (lane == 63) wt[wave] = inc;
    __syncthreads();
    float pre = inc - s;
#pragma unroll
    for (int w = 0; w < 8; ++w) if (w < wave) pre += wt[w];
#pragma unroll
    for (int i = 0; i < 17; ++i) { const int t = t0 + i; pre += v[i]; if (t < TT) dst[t] = -pre * LOG2E; }
    __syncthreads();
}

__device__ __forceinline__ void poolgate_phase(KP p, int l) {
    const int gid = blockIdx.x * 512 + tid_opaque();
    constexpr int RUN = 36, NRUN = TT / RUN;
    static_assert(NRUN * RUN == TT, "runs");
    const bf16_t* Z = (const bf16_t*)(p->ws + WS_Z); const bf16_t* SGP = (const bf16_t*)(p->ws + WS_Z + 4 * SLOT); bf16_t* MRG = (bf16_t*)p->out;
    for (int id = gid; id < NB * NRUN * 128; id += gridDim.x * 512) {
        const int ct = id & 127, rr = id >> 7, b = rr / NRUN, run = rr - b * NRUN;
        const int t0 = run * RUN;
        const int c0 = ct * 8, g = c0 >> 8, w = 2 << g;
        const bf16_t* Zc = Z + (size_t)b * TT * DM + c0; const bf16_t* Gc = SGP + (size_t)b * TT * DM + c0; bf16_t* Mc = MRG + c0;
        float sc[8];
        { const f32x4 a = *(const f32x4*)(p->pool_scale + (size_t)l * DM + c0), bq = *(const f32x4*)(p->pool_scale + (size_t)l * DM + c0 + 4);
          sc[0] = a.x; sc[1] = a.y; sc[2] = a.z; sc[3] = a.w; sc[4] = bq.x; sc[5] = bq.y; sc[6] = bq.z; sc[7] = bq.w; }
        float sum[8];
#pragma unroll
        for (int i = 0; i < 8; ++i) sum[i] = 0.f;
#define PG_ACC(S_, zv) do { sum[0] S_ bf_lo(zv.x); sum[1] S_ bf_hi(zv.x); sum[2] S_ bf_lo(zv.y); sum[3] S_ bf_hi(zv.y); sum[4] S_ bf_lo(zv.z); sum[5] S_ bf_hi(zv.z); sum[6] S_ bf_lo(zv.w); sum[7] S_ bf_hi(zv.w); } while (0)
        { u32x4 hz[15];
#pragma unroll
          for (int i = 0; i < 15; ++i) { const int t = t0 - 15 + i; hz[i] = *(const u32x4*)(Zc + (size_t)(t > 0 ? t : 0) * DM); }
#pragma unroll
          for (int i = 0; i < 15; ++i) { const int t = t0 - 15 + i; if (t >= 0 && t > t0 - w) PG_ACC(+=, hz[i]); } }
        for (int tb = t0; tb < t0 + RUN; tb += 4) {
            u32x4 zv[4], gv[4], zo[4];
#pragma unroll
            for (int i = 0; i < 4; ++i) { const int t = tb + i; const int tl = t - w + 1;
                zv[i] = *(const u32x4*)(Zc + (size_t)t * DM); gv[i] = *(const u32x4*)(Gc + (size_t)t * DM); zo[i] = *(const u32x4*)(Zc + (size_t)(tl > 0 ? tl : 0) * DM); }
#pragma unroll
            for (int i = 0; i < 4; ++i) { const int t = tb + i; const int tl = t - w + 1;
                const float zz[8] = {bf_lo(zv[i].x), bf_hi(zv[i].x), bf_lo(zv[i].y), bf_hi(zv[i].y), bf_lo(zv[i].z), bf_hi(zv[i].z), bf_lo(zv[i].w), bf_hi(zv[i].w)};
                const float gg[8] = {bf_lo(gv[i].x), bf_hi(gv[i].x), bf_lo(gv[i].y), bf_hi(gv[i].y), bf_lo(gv[i].z), bf_hi(gv[i].z), bf_lo(gv[i].w), bf_hi(gv[i].w)};
                const float inv = 1.0f / (float)((t + 1 < w) ? t + 1 : w);
                float y[8];
#pragma unroll
                for (int e = 0; e < 8; ++e) { sum[e] += zz[e]; y[e] = (sum[e] * inv - zz[e]) * sc[e] * gg[e]; }
                u32x4 o; o.x = pk2(y[0], y[1]); o.y = pk2(y[2], y[3]); o.z = pk2(y[4], y[5]); o.w = pk2(y[6], y[7]);
                *(u32x4*)(Mc + (size_t)compact_row(b, t) * DM) = o;
                if (tl >= 0) PG_ACC(-=, zo[i]); }
        }
#undef PG_ACC
    }
}

constexpr int CW_NORM = 512;
__device__ __forceinline__ void qknorm_phase(KP p, int l, LAS unsigned char* lds) {
    const int tid = tid_opaque(), lane = tid & 63, wave = tid >> 6;
    LAS unsigned* tab = (LAS unsigned*)(lds + 1024);
    if (tid < 64) tab[tid] = 0u;
    __syncthreads();
    const bf16_t* Qg = (const bf16_t*)(p->ws + WS_Z + 1 * SLOT); const bf16_t* Kg = (const bf16_t*)(p->ws + WS_Z + 2 * SLOT);
    const int r0 = blockIdx.x * 129, r1 = (r0 + 129 < MREAL) ? r0 + 129 : MREAL;
    const int b0 = r0 / TT;
    float mq0 = 0.f, mk0 = 0.f, mq1 = 0.f, mk1 = 0.f;
#define SQ2(w) (bf_lo(w) * bf_lo(w) + bf_hi(w) * bf_hi(w))
    for (int rb_ = r0 + wave; rb_ < r1; rb_ += 32) {
        u32x4 qa[4], qb[4], ka[4], kb[4];
#pragma unroll
        for (int i = 0; i < 4; ++i) { const int r = (rb_ + 8 * i < r1) ? rb_ + 8 * i : rb_;
            const u32x4* qp = (const u32x4*)(Qg + (size_t)r * DM) + 2 * lane; const u32x4* kp = (const u32x4*)(Kg + (size_t)r * DM) + 2 * lane;
            qa[i] = qp[0]; qb[i] = qp[1]; ka[i] = kp[0]; kb[i] = kp[1]; }
#pragma unroll
        for (int i = 0; i < 4; ++i) { const int r = rb_ + 8 * i;
            float sq = (SQ2(qa[i].x) + SQ2(qa[i].y)) + (SQ2(qa[i].z) + SQ2(qa[i].w)) + (SQ2(qb[i].x) + SQ2(qb[i].y)) + (SQ2(qb[i].z) + SQ2(qb[i].w));
            float sk = (SQ2(ka[i].x) + SQ2(ka[i].y)) + (SQ2(ka[i].z) + SQ2(ka[i].w)) + (SQ2(kb[i].x) + SQ2(kb[i].y)) + (SQ2(kb[i].z) + SQ2(kb[i].w));
            sq += __shfl_xor(sq, 1); sq += __shfl_xor(sq, 2); sk += __shfl_xor(sk, 1); sk += __shfl_xor(sk, 2);
            if (r < r1) { if (r / TT == b0) { mq0 = fmaxf(mq0, sq); mk0 = fmaxf(mk0, sk); } else { mq1 = fmaxf(mq1, sq); mk1 = fmaxf(mk1, sk); } } }
    }
#undef SQ2
    if ((lane & 3) == 0) { const int h = lane >> 2;
        __hip_atomic_fetch_max(tab + h, __builtin_bit_cast(unsigned, mq0), __ATOMIC_RELAXED, __HIP_MEMORY_SCOPE_WORKGROUP);
        __hip_atomic_fetch_max(tab + 16 + h, __builtin_bit_cast(unsigned, mk0), __ATOMIC_RELAXED, __HIP_MEMORY_SCOPE_WORKGROUP);
        __hip_atomic_fetch_max(tab + 32 + h, __builtin_bit_cast(unsigned, mq1), __ATOMIC_RELAXED, __HIP_MEMORY_SCOPE_WORKGROUP);
        __hip_atomic_fetch_max(tab + 48 + h, __builtin_bit_cast(unsigned, mk1), __ATOMIC_RELAXED, __HIP_MEMORY_SCOPE_WORKGROUP); }
    __syncthreads();
    if (tid < 64) { const int b = b0 + (tid >> 5); const unsigned v = tab[tid];
        if (b < NB && v != 0u) __hip_atomic_fetch_max((unsigned*)(p->ws + WS_CTL) + CW_NORM + ((l * NB + b) * 2 + ((tid >> 4) & 1)) * NH + (tid & 15), v, __ATOMIC_RELAXED, __HIP_MEMORY_SCOPE_AGENT); }
    __syncthreads();
}

namespace att {
constexpr int L_B = 32768, L_WS = 33280, L_OST = 36864, L_Q = 69632;
__device__ __forceinline__ int crow(int r, int hi) { return (r & 3) + 8 * (r >> 2) + 4 * hi; }
__device__ __forceinline__ float max3f(float a, float b, float c) { float r; asm("v_max3_f32 %0, %1, %2, %3" : "=v"(r) : "v"(a), "v"(b), "v"(c)); return r; }
__device__ __forceinline__ float max2f(float a, float b) { float r; asm("v_max_f32_e32 %0, %1, %2" : "=v"(r) : "v"(a), "v"(b)); return r; }
typedef short v4i16_t __attribute__((ext_vector_type(4)));
__device__ __forceinline__ s16x4 vtr(const LAS unsigned char* p) { return __builtin_bit_cast(s16x4, __builtin_amdgcn_ds_read_tr16_b64_v4i16((LAS v4i16_t*)p)); }

__device__ __forceinline__ void attn_unit(int b, int h, int q0, int nrows, const bf16_t* Qg, const bf16_t* Kg, const bf16_t* Vg, const bf16_t* SGA, bf16_t* MRG,
                                          const float* FBbh, float skipB, bool dostore, LAS unsigned char* shm) {
    const int tid = tid_opaque(), lane = tid & 63, r32 = lane & 31, hi = lane >> 5; const int wid = __builtin_amdgcn_readfirstlane(tid >> 6);
    const size_t rowbase = (size_t)b * TT;
    const int qw0 = q0 + 32 * wid, lastq = q0 + nrows - 1, NT = lastq / 64 + 1;
    const bool wact = (32 * wid < nrows);
    const int qabs = qw0 + r32;
    bf16x8 qr[4];
    { const int qrow = qabs < TT ? qabs : TT - 1; const bf16_t* qp = Qg + (rowbase + qrow) * DM + h * HD + hi * 8;
#pragma unroll
      for (int d0 = 0; d0 < 4; ++d0) qr[d0] = *(const bf16x8*)(qp + d0 * 16); }
    const bf16_t* ksrc = Kg + (rowbase + lane) * DM + h * HD + wid * 8;
    const bf16_t* vsrc = Vg + (rowbase + 16 * (wid & 3) + (lane >> 2)) * DM + h * HD + (wid >> 2) * 32 + (lane & 3) * 8;
    const unsigned stoff = (unsigned)wid * 1024u + (unsigned)lane * 16u;
    int j0;
    { LAS unsigned* wc = (LAS unsigned*)(shm + L_Q + 64);
      const float limit = FBbh[q0] - skipB;
      bool pred = false;
      if (tid < NT) { const int ke = 64 * tid + 63; pred = FBbh[ke < TT ? ke : TT - 1] < limit; }
      const unsigned long long bal = __ballot(pred);
      if (lane == 0) wc[wid] = (unsigned)__popcll(bal);
      __syncthreads();
      j0 = (int)(wc[0] + wc[1] + wc[2]);
      if (j0 > NT - 1) j0 = NT - 1; }
    u32x4 kreg = *(const u32x4*)(ksrc + (size_t)j0 * 64 * DM), vreg = *(const u32x4*)(vsrc + (size_t)j0 * 64 * DM); float breg = (tid < 64) ? FBbh[j0 * 64 + tid] : 0.f;
    { const int nb0 = (j0 & 1) * 16384; *(LAS u32x4*)(shm + nb0 + stoff) = kreg; *(LAS u32x4*)(shm + nb0 + 8192 + stoff) = vreg; if (tid < 64) ((LAS float*)(shm + L_B + (j0 & 1) * 256))[tid] = breg; }
    if (j0 + 1 < NT) { kreg = *(const u32x4*)(ksrc + (size_t)(j0 + 1) * 64 * DM); vreg = *(const u32x4*)(vsrc + (size_t)(j0 + 1) * 64 * DM); if (tid < 64) breg = FBbh[(j0 + 1) * 64 + tid]; }
    u32x4 kreg2 = kreg, vreg2 = vreg; float breg2 = breg;
    __syncthreads();
    float m = NEGBIG, l = 0.f; f32x16 o0, o1;
#pragma unroll
    for (int r = 0; r < 16; ++r) { o0[r] = 0.f; o1[r] = 0.f; }
    LAS float* wsf = (LAS float*)(shm + L_WS + wid * 256);
    for (int jj = j0; jj < NT; jj += 2) {
#pragma unroll
      for (int half = 0; half < 2; ++half) {
        const int j = jj + half; if (j >= NT) break;
        const int cur = j & 1; const bool more = (j + 1 < NT);
        if (j + 2 < NT) {
            if (half == 0) { kreg2 = *(const u32x4*)(ksrc + (size_t)(j + 2) * 64 * DM); vreg2 = *(const u32x4*)(vsrc + (size_t)(j + 2) * 64 * DM); if (tid < 64) breg2 = FBbh[(j + 2) * 64 + tid]; }
            else           { kreg  = *(const u32x4*)(ksrc + (size_t)(j + 2) * 64 * DM); vreg  = *(const u32x4*)(vsrc + (size_t)(j + 2) * 64 * DM); if (tid < 64) breg  = FBbh[(j + 2) * 64 + tid]; } }
        if (wact && 64 * j <= qw0 + 31) {
            const LAS unsigned char* Kb = shm + cur * 16384; const LAS unsigned char* Vb = Kb + 8192; const LAS float* bias = (const LAS float*)(shm + L_B + cur * 256);
            f32x16 p0, p1;
#pragma unroll
            for (int g = 0; g < 4; ++g) { const f32x4 a = *(const LAS f32x4*)(bias + 8 * g + 4 * hi), c = *(const LAS f32x4*)(bias + 32 + 8 * g + 4 * hi);
                p0[4 * g] = a.x; p0[4 * g + 1] = a.y; p0[4 * g + 2] = a.z; p0[4 * g + 3] = a.w; p1[4 * g] = c.x; p1[4 * g + 1] = c.y; p1[4 * g + 2] = c.z; p1[4 * g + 3] = c.w; }
            const LAS unsigned char* kb = Kb + hi * 1024 + r32 * 16;
#pragma unroll
            for (int d0 = 0; d0 < 4; ++d0) { const bf16x8 b0 = *(const LAS bf16x8*)(kb + d0 * 2048), b1 = *(const LAS bf16x8*)(kb + d0 * 2048 + 512);
                p0 = __builtin_amdgcn_mfma_f32_32x32x16_bf16(b0, qr[d0], p0, 0, 0, 0); p1 = __builtin_amdgcn_mfma_f32_32x32x16_bf16(b1, qr[d0], p1, 0, 0, 0); }
            asm volatile("s_nop 15\n\ts_nop 7" : "+v"(p0), "+v"(p1));
            if (64 * j + 63 > qw0) {
                const int kbase = 64 * j + 4 * hi;
#pragma unroll
                for (int r = 0; r < 16; ++r) { const int kv = kbase + (r & 3) + 8 * (r >> 2); if (kv > qabs) p0[r] = NEGBIG; if (kv + 32 > qabs) p1[r] = NEGBIG; }
            }
            float ta = max3f(p0[0], p0[1], p1[0]), tb = max3f(p0[2], p0[3], p1[1]); ta = max3f(ta, p1[2], p1[3]);
#pragma unroll
            for (int r = 4; r < 16; r += 4) { ta = max3f(ta, p0[r], p0[r + 1]); tb = max3f(tb, p0[r + 2], p0[r + 3]); ta = max3f(ta, p1[r], p1[r + 1]); tb = max3f(tb, p1[r + 2], p1[r + 3]); }
            float tmax = max2f(ta, tb);
            { auto rr_ = __builtin_amdgcn_permlane32_swap(__float_as_uint(tmax), __float_as_uint(tmax), false, false);
              tmax = max2f(__uint_as_float(rr_[0]), __uint_as_float(rr_[1])); }
            const bool grow = __any(tmax > m + 8.0f);
            if (grow) {
                const float mn = max2f(m, tmax); const float alpha = __builtin_amdgcn_exp2f(m - mn); m = mn; l *= alpha;
                if (hi == 0) wsf[r32] = alpha;
            }
            p0 = p0 - m; p1 = p1 - m;
#pragma unroll
            for (int r = 0; r < 16; ++r) { p0[r] = __builtin_amdgcn_exp2f(p0[r]); p1[r] = __builtin_amdgcn_exp2f(p1[r]); }
            { const f32x16 ps = p0 + p1;
              l += ((ps[0] + ps[1]) + (ps[2] + ps[3])) + ((ps[4] + ps[5]) + (ps[6] + ps[7])) + (((ps[8] + ps[9]) + (ps[10] + ps[11])) + ((ps[12] + ps[13]) + (ps[14] + ps[15]))); }
            u32x4 pw0, pw1, pw2, pw3;
            pw0 = (u32x4){cvtpk_s(p0[0], p0[1]), cvtpk_s(p0[2], p0[3]), cvtpk_s(p0[4], p0[5]), cvtpk_s(p0[6], p0[7])};
            pw1 = (u32x4){cvtpk_s(p0[8], p0[9]), cvtpk_s(p0[10], p0[11]), cvtpk_s(p0[12], p0[13]), cvtpk_s(p0[14], p0[15])};
            pw2 = (u32x4){cvtpk_s(p1[0], p1[1]), cvtpk_s(p1[2], p1[3]), cvtpk_s(p1[4], p1[5]), cvtpk_s(p1[6], p1[7])};
            pw3 = (u32x4){cvtpk_s(p1[8], p1[9]), cvtpk_s(p1[10], p1[11]), cvtpk_s(p1[12], p1[13]), cvtpk_s(p1[14], p1[15])};
            if (grow) {
#pragma unroll
                for (int g = 0; g < 4; ++g) { const f32x4 a = *(const LAS f32x4*)(wsf + 8 * g + 4 * hi);
                    o0[4 * g] *= a.x; o0[4 * g + 1] *= a.y; o0[4 * g + 2] *= a.z; o0[4 * g + 3] *= a.w; o1[4 * g] *= a.x; o1[4 * g + 1] *= a.y; o1[4 * g + 2] *= a.z; o1[4 * g + 3] *= a.w; }
            }
            const LAS unsigned char* vp = Vb + ((lane >> 4) & 1) * 32 + (lane & 3) * 8 + (4 * hi + ((lane & 15) >> 2)) * 64;
#define ATT_PV(OD, D0, KS, PW) do { const s16x4 lo_ = vtr(vp + (D0) * 4096 + (KS) * 1024), hi_ = vtr(vp + (D0) * 4096 + (KS) * 1024 + 512); \
                const bf16x8 vf_ = (bf16x8){lo_[0], lo_[1], lo_[2], lo_[3], hi_[0], hi_[1], hi_[2], hi_[3]}; \
                OD = __builtin_amdgcn_mfma_f32_32x32x16_bf16(__builtin_bit_cast(bf16x8, PW), vf_, OD, 0, 0, 0); } while (0)
            ATT_PV(o0, 0, 0, pw0); ATT_PV(o1, 1, 0, pw0); ATT_PV(o0, 0, 1, pw1); ATT_PV(o1, 1, 1, pw1);
            ATT_PV(o0, 0, 2, pw2); ATT_PV(o1, 1, 2, pw2); ATT_PV(o0, 0, 3, pw3); ATT_PV(o1, 1, 3, pw3);
#undef ATT_PV
        }
        if (more) { const int nb = (cur ^ 1) * 16384;
            if (half == 0) { *(LAS u32x4*)(shm + nb + stoff) = kreg;  *(LAS u32x4*)(shm + nb + 8192 + stoff) = vreg;  if (tid < 64) ((LAS float*)(shm + L_B + (cur ^ 1) * 256))[tid] = breg; }
            else           { *(LAS u32x4*)(shm + nb + stoff) = kreg2; *(LAS u32x4*)(shm + nb + 8192 + stoff) = vreg2; if (tid < 64) ((LAS float*)(shm + L_B + (cur ^ 1) * 256))[tid] = breg2; } }
        __syncthreads();
      }
    }
    if (wact) {
        l += __shfl_xor(l, 32);
        if (hi == 0) wsf[r32] = 1.0f / l;
        float rli[16];
#pragma unroll
        for (int g = 0; g < 4; ++g) { const f32x4 a = *(const LAS f32x4*)(wsf + 8 * g + 4 * hi); rli[4 * g] = a.x; rli[4 * g + 1] = a.y; rli[4 * g + 2] = a.z; rli[4 * g + 3] = a.w; }
        LAS bf16_t* stg = (LAS bf16_t*)(shm + L_OST + wid * 4096);
#pragma unroll
        for (int r = 0; r < 16; ++r) { const int orow = crow(r, hi); stg[orow * 64 + r32] = (bf16_t)f2bf(o0[r] * rli[r]); stg[orow * 64 + 32 + r32] = (bf16_t)f2bf(o1[r] * rli[r]); }
        asm volatile("s_waitcnt lgkmcnt(0)" ::: "memory");
#pragma unroll
        for (int i = 0; i < 4; ++i) { const int row = i * 8 + (lane >> 3), ch = lane & 7; const int grow = qw0 + row;
            const u32x4 ov = *(const LAS u32x4*)(stg + row * 64 + ch * 8);
            if (grow <= lastq && dostore) { const size_t off = (rowbase + grow) * DM + h * HD + ch * 8; const size_t moff = (size_t)compact_row(b, grow) * DM + h * HD + ch * 8;
                const u32x4 mg = *(const u32x4*)(MRG + moff), sg = *(const u32x4*)(SGA + off); u32x4 w;
                w.x = pk2(bf_lo(mg.x) + bf_lo(sg.x) * bf_lo(ov.x), bf_hi(mg.x) + bf_hi(sg.x) * bf_hi(ov.x));
                w.y = pk2(bf_lo(mg.y) + bf_lo(sg.y) * bf_lo(ov.y), bf_hi(mg.y) + bf_hi(sg.y) * bf_hi(ov.y));
                w.z = pk2(bf_lo(mg.z) + bf_lo(sg.z) * bf_lo(ov.z), bf_hi(mg.z) + bf_hi(sg.z) * bf_hi(ov.z));
                w.w = pk2(bf_lo(mg.w) + bf_lo(sg.w) * bf_lo(ov.w), bf_hi(mg.w) + bf_hi(sg.w) * bf_hi(ov.w));
                *(u32x4*)(MRG + moff) = w; } }
    }
    __syncthreads();
}

__device__ __forceinline__ void attn_phase(KP p, int l, int pass, LAS unsigned char* shm) {
    unsigned* ctr = (unsigned*)(p->ws + WS_CTL) + 64 * (l + DEPTH * pass);
    const bool dostore = (pass == 0);
    const bf16_t* Qg = (const bf16_t*)(p->ws + WS_Z + 1 * SLOT); const bf16_t* Kg = (const bf16_t*)(p->ws + WS_Z + 2 * SLOT); const bf16_t* Vg = (const bf16_t*)(p->ws + WS_Z + 3 * SLOT);
    const bf16_t* SGA = (const bf16_t*)(p->ws + WS_Z + 5 * SLOT); bf16_t* MRG = (bf16_t*)p->out;
    const float* FB = (const float*)(p->ws + WS_FB);
    LAS unsigned* qw = (LAS unsigned*)(shm + 140032);
    constexpr int NUNITS = 64 * 33;
    unsigned nxt = 0u;
    if (threadIdx.x == 0) nxt = __hip_atomic_fetch_add(ctr, 1u, __ATOMIC_RELAXED, __HIP_MEMORY_SCOPE_AGENT);
    for (int qs = 0;; qs ^= 1) {
        if (threadIdx.x == 0) qw[qs] = nxt;
        __syncthreads();
        const int idx = (int)qw[qs];
        if (threadIdx.x == 0) nxt = __hip_atomic_fetch_add(ctr, 1u, __ATOMIC_RELAXED, __HIP_MEMORY_SCOPE_AGENT);
        if (idx >= NUNITS) {
            const int ci = idx - NUNITS;
            if (pass != 0 || ci >= conv_count(l + 1, true) * PROBE_CONV_REPS) break;
            conv_wg_item(p, l + 1, l, ci % conv_count(l + 1, true), shm);
            continue; }
        const int qb = 32 - idx / 64, bh = idx % 64;
        const int q0 = qb == 0 ? 0 : META + 256 * (qb - 1), nrows = qb == 0 ? META : 256;
        const unsigned* nt = (const unsigned*)(p->ws + WS_CTL) + CW_NORM + ((l * NB + (bh >> 4)) * 2) * NH + (bh & 15);
        const float qn2 = __builtin_bit_cast(float, nt[0]), kn2 = __builtin_bit_cast(float, nt[NH]);
        const float skipB = 38.0f + 2.0f * sqrtf(qn2) * sqrtf(kn2) * 1.001f;
        attn_unit(bh >> 4, bh & 15, q0, nrows, Qg, Kg, Vg, SGA, MRG, FB + (size_t)bh * TT, skipB, dostore, shm);
    }
}
}


#define XB_TMO      128
#define XB_XCNT(j)  (256  + 64 * (j))
#define XB_XSUB(j)  (1280 + 64 * (j))
#define XB_XGEN(j)  (2304 + 64 * (j))
#define XB_TOP      3328
#define XB_TOPGEN   3392
#define XCD_BAR_WORDS 3456
#define XB_SPIN_CAP (1u << 22)
constexpr int CW_BAR = 1024;
constexpr size_t CTL_ZERO_BYTES = (size_t)(CW_BAR + XCD_BAR_WORDS) * 4;
constexpr int LDS_XB = 139264 + 256;
__device__ __forceinline__ unsigned xb_ld(unsigned* p)              { return __hip_atomic_load(p, __ATOMIC_RELAXED, __HIP_MEMORY_SCOPE_AGENT); }
__device__ __forceinline__ unsigned xb_add(unsigned* p, unsigned v) { return __hip_atomic_fetch_add(p, v, __ATOMIC_RELAXED, __HIP_MEMORY_SCOPE_AGENT); }
__device__ __forceinline__ unsigned xb_xcc_id() { return (unsigned)__builtin_amdgcn_s_getreg((3 << 11) | 20) & 0xFu; }
#define XB_SPIN(cond, bar) do { unsigned _sp = 0; while (cond) { __builtin_amdgcn_s_sleep(1); \
    if ((++_sp & 255u) == 0u) { if (xb_ld(&(bar)[XB_TMO])) break; if (_sp > XB_SPIN_CAP) { atomicAdd(&(bar)[XB_TMO], 1u); break; } } } } while (0)
struct XcdBarrier { unsigned* bar; unsigned x; volatile LAS unsigned* st; };
__device__ __forceinline__ XcdBarrier xcd_barrier_post(unsigned* bar, volatile LAS unsigned* st) {
    XcdBarrier b; b.bar = bar; b.x = xb_xcc_id(); b.st = st;
    if (threadIdx.x == 0) (void)xb_add(&bar[XB_XCNT(b.x)], 1u);
    return b;
}
__device__ __forceinline__ void xcd_barrier_complete(unsigned* bar, unsigned x, unsigned& nloc, unsigned& nx) {
    const unsigned G = gridDim.x * gridDim.y * gridDim.z;
    unsigned sum, cnt, mine, sp = 0u;
    for (;;) {
        sum = 0u; cnt = 0u; mine = 0u;
#pragma unroll
        for (unsigned j = 0; j < 16; ++j) { const unsigned c = xb_ld(&bar[XB_XCNT(j)]); sum += c; cnt += (c > 0u) ? 1u : 0u; mine = (j == x) ? c : mine; }
        if (sum == G) break;
        __builtin_amdgcn_s_sleep(1);
        if ((++sp & 255u) == 0u) { if (xb_ld(&bar[XB_TMO])) break; if (sp > XB_SPIN_CAP) { atomicAdd(&bar[XB_TMO], 1u); break; } }
    }
    nloc = mine > 0u ? mine : 1u; nx = cnt > 0u ? cnt : 1u;
}
__device__ __forceinline__ void xcd_barrier(unsigned* bar, volatile LAS unsigned* st) {
    asm volatile("s_waitcnt vmcnt(0)" ::: "memory");
    __syncthreads();
    if (threadIdx.x == 0) {
        const unsigned x = xb_xcc_id();
        __builtin_amdgcn_s_waitcnt(0);
        unsigned nloc = st[0], nx = st[1];
        if (nloc == 0u) { xcd_barrier_complete(bar, x, nloc, nx); st[0] = nloc; st[1] = nx; }
        const unsigned old = xb_add(&bar[XB_XSUB(x)], 1u);
        const unsigned gen = old / nloc;
        if (old + 1u == (gen + 1u) * nloc) {
            __builtin_amdgcn_fence(__ATOMIC_RELEASE, "agent");
            asm volatile("s_waitcnt vmcnt(0)" ::: "memory");
            const unsigned og = xb_add(&bar[XB_TOP], 1u);
            const unsigned tg = og / nx;
            if (og + 1u == (tg + 1u) * nx) xb_add(&bar[XB_TOPGEN], 1u);
            else XB_SPIN(xb_ld(&bar[XB_TOPGEN]) == tg, bar);
            __builtin_amdgcn_fence(__ATOMIC_ACQUIRE, "agent");
            xb_add(&bar[XB_XGEN(x)], 1u);
            asm volatile("s_waitcnt vmcnt(0)" ::: "memory");
        } else {
            XB_SPIN(xb_ld(&bar[XB_XGEN(x)]) == gen, bar);
            __builtin_amdgcn_fence(__ATOMIC_ACQUIRE, "agent");
            asm volatile("s_waitcnt vmcnt(0)" ::: "memory");
        }
    }
    __syncthreads();
}

__global__ void __launch_bounds__(512, 2) mega_fwd(Params p_unused) {
    extern __shared__ __attribute__((aligned(16))) unsigned char lds_raw[];
    LAS unsigned char* lds = (LAS unsigned char*)lds_raw;
    cg::grid_group grid = cg::this_grid();
    { unsigned* ctl0 = (unsigned*)(params_opaque()->ws + WS_CTL);
      if (threadIdx.x == 0) { ((volatile LAS unsigned*)(lds + LDS_XB))[0] = 0u; ((volatile LAS unsigned*)(lds + LDS_XB))[1] = 0u; }
      if (blockIdx.x == 0) { unsigned zz = 0u; asm volatile("" : "+v"(zz));
          for (int i = (int)threadIdx.x; i < (int)(CTL_ZERO_BYTES / 4); i += 512) ctl0[i] = zz; } }
    __syncthreads();

    { KP p = params_opaque();
      for (int ci = blockIdx.x; ci < CV_Z + CV_IN8; ci += gridDim.x) conv_wg_item(p, 0, 0, ci, lds);
      norm_pass<0>(p, nullptr);
    }
    grid.sync();
    { unsigned* barw = (unsigned*)(params_opaque()->ws + WS_CTL) + CW_BAR; const unsigned xcc = xb_xcc_id();
      if (threadIdx.x == 0) (void)xb_add(barw + XB_XCNT(xcc), 1u); }

#pragma unroll 1
    for (int l = 0; l < DEPTH; ++l) {
        { KP p = params_opaque(); unsigned char* ws = p->ws;
          pg8::Gemm g{(const bf16_t*)(ws + WS_HB), (const bf16_t*)(ws + WS_WIN), MM, NIN, DM}; pg8::StaticOrder S; S.init(MM, NIN, (int)gridDim.x, (int)blockIdx.x);
          { const int t = tid_opaque(); if (t < NH) ((LAS float*)(lds + LDS_BF))[t] = p->b_forget[l * NH + t]; }
          __syncthreads();
          { sk::EpiInM EM{(bf16_t*)(ws + WS_Z), (LAS const float*)(lds + LDS_BF), (const float*)(ws + WS_RSTD)}; sk::phase<DM>(lds, (const bf16_t*)(ws + WS_HB) + (size_t)MM * DM, (const bf16_t*)(ws + WS_WIN), EM, (int)gridDim.x / 2, (int)gridDim.x - (int)gridDim.x / 2); }
          pg8::EpiIn E{(bf16_t*)(ws + WS_Z), (LAS const float*)(lds + LDS_BF), (const float*)(ws + WS_RSTD)};
          _Pragma("unroll 1") for (int rep = 0; rep < PROBE_GEMM_REPS * PROBE_A_REPS; ++rep) pg8::gemm_phase<pg8::EpiIn, pg8::StaticOrder, true>(lds, g, S, E); }
        GSYNC();
        { KP p = params_opaque();
          _Pragma("unroll 1") for (int rep = 0; rep < PROBE_S_REPS; ++rep) {
          if (blockIdx.x < 64) scan_unit(p, (int)blockIdx.x, lds);
          qknorm_phase(p, l, lds);
          poolgate_phase(p, l); } }
        GSYNC();
        { KP p = params_opaque(); _Pragma("unroll 1") for (int pass = 0; pass < PROBE_ATT_REPS; ++pass) att::attn_phase(p, l, pass, lds); }
        GSYNC();
        { KP p = params_opaque(); unsigned char* ws = p->ws;
          { sk::EpiPlainM EM{(bf16_t*)(ws + WS_MIX)}; sk::phase<DM>(lds, (const bf16_t*)p->out + (size_t)MM * DM, (const bf16_t*)(ws + WS_WOUT), EM, 0, (int)gridDim.x); }
          pg8::Gemm g{(const bf16_t*)p->out, (const bf16_t*)(ws + WS_WOUT), MM, DM, DM}; pg8::StaticOrder S; S.init(MM, DM, (int)gridDim.x, (int)blockIdx.x);
          pg8::EpiPlain E{(bf16_t*)(ws + WS_MIX), DM};
          _Pragma("unroll 1") for (int rep = 0; rep < PROBE_GEMM_REPS * PROBE_C_REPS; ++rep) pg8::gemm_phase<pg8::EpiPlain, pg8::StaticOrder, true>(lds, g, S, E); }
        GSYNC();
        { KP p = params_opaque(); _Pragma("unroll 1") for (int rep = 0; rep < PROBE_NORM_DRY; ++rep) norm_pass<1, true>(p, p->n_mix_post + l * DM);
          norm_pass<1>(p, p->n_mix_post + l * DM); }
        GSYNC();
        { KP p = params_opaque(); unsigned char* ws = p->ws;
          { sk::EpiSwigluM EM{(bf16_t*)(ws + WS_FF), (const float*)(ws + WS_RSTD)}; sk::phase<DM>(lds, (const bf16_t*)(ws + WS_HB) + (size_t)MM * DM, (const bf16_t*)(ws + WS_WGU), EM, 0, (int)gridDim.x); }
          pg8::Gemm g{(const bf16_t*)(ws + WS_HB), (const bf16_t*)(ws + WS_WGU), MM, NGU, DM}; pg8::StaticOrder S; S.init(MM, NGU, (int)gridDim.x, (int)blockIdx.x);
          pg8::EpiSwiglu E{(bf16_t*)(ws + WS_FF), (const float*)(ws + WS_RSTD)};
          _Pragma("unroll 1") for (int rep = 0; rep < PROBE_GEMM_REPS * PROBE_D_REPS; ++rep) pg8::gemm_phase<pg8::EpiSwiglu, pg8::StaticOrder, true>(lds, g, S, E); }
        GSYNC();
        { KP p = params_opaque(); unsigned char* ws = p->ws;
          { sk::EpiPlainM EM{(bf16_t*)(ws + WS_MIX)}; sk::phase<DFF>(lds, (const bf16_t*)(ws + WS_FF) + (size_t)MM * DFF, (const bf16_t*)(ws + WS_WDN), EM, 0, (int)gridDim.x); }
          pg8::Gemm g{(const bf16_t*)(ws + WS_FF), (const bf16_t*)(ws + WS_WDN), MM, DM, DFF}; pg8::StaticOrder S; S.init(MM, DM, (int)gridDim.x, (int)blockIdx.x);
          pg8::EpiPlain E{(bf16_t*)(ws + WS_MIX), DM};
          _Pragma("unroll 1") for (int rep = 0; rep < PROBE_GEMM_REPS * PROBE_E_REPS; ++rep) pg8::gemm_phase<pg8::EpiPlain, pg8::StaticOrder, true>(lds, g, S, E); }
        GSYNC();
        { KP p = params_opaque();
          if (l + 1 < DEPTH) norm_pass<1>(p, p->n_ffn_post + l * DM); else norm_pass<2>(p, p->n_ffn_post + l * DM); }
        if (l + 1 < DEPTH) GSYNC();
    }
}

extern "C" void kernel_launch(void* const* d_in, const int* in_sizes, int n_in, void* d_out, int out_size, void* d_ws, size_t ws_size, hipStream_t stream) {
    static int grid_blocks = 0;
    if (grid_blocks == 0) {
        if (n_in != 14 || ws_size < WS_END) { fprintf(stderr, "kernel_launch: unexpected n_in %d or ws_size %zu (< %zu)\n", n_in, ws_size, (size_t)WS_END); grid_blocks = -1; return; }
        int dev = 0, cus = 0, per_cu = 0;
        hipGetDevice(&dev);
        hipDeviceGetAttribute(&cus, hipDeviceAttributeMultiprocessorCount, dev);
        if (hipFuncSetAttribute((const void*)mega_fwd, hipFuncAttributeMaxDynamicSharedMemorySize, LDS_BYTES) != hipSuccess) { fprintf(stderr, "kernel_launch: hipFuncSetAttribute failed\n"); grid_blocks = -1; return; }
        hipOccupancyMaxActiveBlocksPerMultiprocessor(&per_cu, (const void*)mega_fwd, 512, LDS_BYTES);
        if (per_cu < 1) per_cu = 1;
        grid_blocks = cus * per_cu;
        (void)hipGetLastError();
    }
    if (grid_blocks < 0) return;
    Params p{};
    p.x = (const float*)d_in[0]; p.meta = (const float*)d_in[1]; p.n_mix_pre = (const float*)d_in[2]; p.n_mix_post = (const float*)d_in[3];
    p.n_ffn_pre = (const float*)d_in[4]; p.n_ffn_post = (const float*)d_in[5]; p.w_in = (const float*)d_in[6]; p.b_forget = (const float*)d_in[7];
    p.w_pool = (const float*)d_in[8]; p.pool_scale = (const float*)d_in[9]; p.w_out = (const float*)d_in[10]; p.w_gate = (const float*)d_in[11];
    p.w_up = (const float*)d_in[12]; p.w_down = (const float*)d_in[13];
    p.out = (float*)d_out; p.ws = (unsigned char*)d_ws;
    void* args[] = {&p};
    hipError_t e = hipLaunchCooperativeKernel((const void*)mega_fwd, dim3(grid_blocks), dim3(512), args, LDS_BYTES, stream);
    if (e != hipSuccess) fprintf(stderr, "cooperative launch failed: %s (grid %d)\n", hipGetErrorString(e), grid_blocks);
}
```
